# Optimizing an MI355X kernel written in HIP

```python
import jax, jax.numpy as jnp
from jax import lax
import numpy as np

D_MODEL = 1024
BATCH = 32
SEQ = 2048
DEPTH = 2

GRID_W = 64
Q_BLOCK = 128
ROPE_THETA = 10000.0
NORM_EPS = 1e-6
MLA_HEADS = 8
MLA_Q_RANK = 384
MLA_KV_RANK = 256
MLA_NOPE_DIM = 64
MLA_ROPE_DIM = 32
MLA_V_DIM = 64
MLA_QK_DIM = MLA_NOPE_DIM + MLA_ROPE_DIM
MLA_OUT = MLA_HEADS * MLA_V_DIM
GQA_Q_HEADS = 8
GQA_KV_HEADS = 2
GQA_GROUP = GQA_Q_HEADS // GQA_KV_HEADS
GQA_HEAD_DIM = 64
GQA_OUT = GQA_Q_HEADS * GQA_HEAD_DIM
N_BRANCHES = 2
D_FF = 2816
N_MOD = 9
IN_SIZES = (MLA_Q_RANK, MLA_KV_RANK, MLA_ROPE_DIM,
            GQA_Q_HEADS * GQA_HEAD_DIM, GQA_KV_HEADS * GQA_HEAD_DIM, GQA_KV_HEADS * GQA_HEAD_DIM,
            N_BRANCHES * D_MODEL)
D_IN = sum(IN_SIZES)

kernel_name = 'hybrid_mla_gqa_axial_macaron_adaln_encoder'


def _rmsnorm(x, g):
    x32 = x.astype(jnp.float32)
    y = x32 * lax.rsqrt(jnp.mean(x32 * x32, axis=-1, keepdims=True) + NORM_EPS)
    return (y * g.astype(jnp.float32)).astype(x.dtype)


def _split_cols(z, sizes):
    out, start = [], 0
    for s in sizes:
        out.append(z[..., start:start + s])
        start += s
    return out


def _rope_tables(pos, dim):
    inv = ROPE_THETA ** (-jnp.arange(0, dim, 2, dtype=jnp.float32) / dim)
    ang = pos.astype(jnp.float32)[:, None] * inv[None, :]
    return jnp.cos(ang), jnp.sin(ang)


def _apply_rope(x, cos, sin):
    x32 = x.astype(jnp.float32)
    x1, x2 = jnp.split(x32, 2, axis=-1)
    c = cos[None, :, None, :]
    s = sin[None, :, None, :]
    return jnp.concatenate([x1 * c - x2 * s, x2 * c + x1 * s], axis=-1).astype(x.dtype)


def _axial_rope(x, row_cs, col_cs):
    half = x.shape[-1] // 2
    return jnp.concatenate([_apply_rope(x[..., :half], *row_cs),
                            _apply_rope(x[..., half:], *col_cs)], axis=-1)


def _block_attention(q, k, v, scale):
    B, S, Hk, G, Dq = q.shape
    nb = S // Q_BLOCK
    qb = q.reshape(B, nb, Q_BLOCK, Hk, G, Dq).transpose(1, 0, 2, 3, 4, 5)

    def one_block(q_blk):
        s = jnp.einsum('bqhgd,bshd->bhgqs', q_blk, k, preferred_element_type=jnp.float32) * scale
        p = jax.nn.softmax(s, axis=-1).astype(v.dtype)
        return jnp.einsum('bhgqs,bshd->bqhgd', p, v)

    o = lax.map(one_block, qb)
    return o.transpose(1, 0, 2, 3, 4, 5).reshape(B, S, Hk * G * v.shape[-1])


def _swiglu(x, w_in, w_out):
    a, b = jnp.split(x @ w_in, 2, axis=-1)
    return (jax.nn.silu(a) * b) @ w_out


def _modulate(xn, shift, scale):
    return xn * (1.0 + scale) + shift


def _mla(z_q, z_kv, z_kr, q_a_norm, w_uq, kv_a_norm, w_ukv, qk_q_norm, qk_k_norm, pos_cs):
    B, S, _ = z_q.shape
    q = (_rmsnorm(z_q, q_a_norm) @ w_uq).reshape(B, S, MLA_HEADS, MLA_QK_DIM)
    kv = (_rmsnorm(z_kv, kv_a_norm) @ w_ukv).reshape(B, S, MLA_HEADS, MLA_NOPE_DIM + MLA_V_DIM)
    k_nope, v = kv[..., :MLA_NOPE_DIM], kv[..., MLA_NOPE_DIM:]
    k_pe = jnp.broadcast_to(z_kr[:, :, None, :], (B, S, MLA_HEADS, MLA_ROPE_DIM))
    k = jnp.concatenate([k_nope, k_pe], axis=-1)
    q = _rmsnorm(q, qk_q_norm)
    k = _rmsnorm(k, qk_k_norm)
    q = jnp.concatenate([q[..., :MLA_NOPE_DIM], _apply_rope(q[..., MLA_NOPE_DIM:], *pos_cs)], axis=-1)
    k = jnp.concatenate([k[..., :MLA_NOPE_DIM], _apply_rope(k[..., MLA_NOPE_DIM:], *pos_cs)], axis=-1)
    return _block_attention(q[:, :, :, None, :], k, v, MLA_QK_DIM ** -0.5)


def _gqa_axial(z_q, z_k, z_v, q_norm, k_norm, row_cs, col_cs):
    B, S, _ = z_q.shape
    q = _rmsnorm(z_q.reshape(B, S, GQA_Q_HEADS, GQA_HEAD_DIM), q_norm)
    k = _rmsnorm(z_k.reshape(B, S, GQA_KV_HEADS, GQA_HEAD_DIM), k_norm)
    v = z_v.reshape(B, S, GQA_KV_HEADS, GQA_HEAD_DIM)
    q = _axial_rope(q, row_cs, col_cs).reshape(B, S, GQA_KV_HEADS, GQA_GROUP, GQA_HEAD_DIM)
    k = _axial_rope(k, row_cs, col_cs)
    return _block_attention(q, k, v, GQA_HEAD_DIM ** -0.5)


def setup_inputs(seed: int = 0) -> dict:
    key = jax.random.key(seed)
    ks = jax.random.split(key, 24)
    f32 = jnp.float32

    def w(k, shape, fan_in):
        return jax.random.normal(k, shape, f32) * (fan_in ** -0.5)

    def gain(k, shape):
        return 1.0 + 0.02 * jax.random.normal(k, shape, f32)

    L = DEPTH
    return {
        'x': jax.random.normal(ks[0], (BATCH, SEQ, D_MODEL), f32),
        'c': jax.random.normal(ks[1], (BATCH, D_MODEL), f32),
        'w_ada': w(ks[2], (L, D_MODEL, N_MOD * D_MODEL), D_MODEL),
        'b_ada': 0.02 * jax.random.normal(ks[3], (L, N_MOD * D_MODEL), f32),
        'norm_ffn1': gain(ks[4], (L, D_MODEL)),
        'w_ffn1_in': w(ks[5], (L, D_MODEL, 2 * D_FF), D_MODEL),
        'w_ffn1_out': w(ks[6], (L, D_FF, D_MODEL), D_FF),
        'norm_mix': gain(ks[7], (L, D_MODEL)),
        'w_in': w(ks[8], (L, D_MODEL, D_IN), D_MODEL),
        'mla_q_a_norm': gain(ks[9], (L, MLA_Q_RANK)),
        'mla_w_uq': w(ks[10], (L, MLA_Q_RANK, MLA_HEADS * MLA_QK_DIM), MLA_Q_RANK),
        'mla_kv_a_norm': gain(ks[11], (L, MLA_KV_RANK)),
        'mla_w_ukv': w(ks[12], (L, MLA_KV_RANK, MLA_HEADS * (MLA_NOPE_DIM + MLA_V_DIM)), MLA_KV_RANK),
        'mla_qk_q_norm': gain(ks[13], (L, MLA_QK_DIM)),
        'mla_qk_k_norm': gain(ks[14], (L, MLA_QK_DIM)),
        'gqa_q_norm': gain(ks[15], (L, GQA_HEAD_DIM)),
        'gqa_k_norm': gain(ks[16], (L, GQA_HEAD_DIM)),
        'w_branch_mla': w(ks[17], (L, MLA_OUT, D_MODEL), MLA_OUT),
        'w_branch_gqa': w(ks[18], (L, GQA_OUT, D_MODEL), GQA_OUT),
        'w_out': w(ks[19], (L, D_MODEL, D_MODEL), D_MODEL),
        'norm_ffn2': gain(ks[20], (L, D_MODEL)),
        'w_ffn2_in': w(ks[21], (L, D_MODEL, 2 * D_FF), D_MODEL),
        'w_ffn2_out': w(ks[22], (L, D_FF, D_MODEL), D_FF),
    }


def reference(x, c, w_ada, b_ada, norm_ffn1, w_ffn1_in, w_ffn1_out, norm_mix, w_in,
              mla_q_a_norm, mla_w_uq, mla_kv_a_norm, mla_w_ukv, mla_qk_q_norm, mla_qk_k_norm,
              gqa_q_norm, gqa_k_norm, w_branch_mla, w_branch_gqa, w_out,
              norm_ffn2, w_ffn2_in, w_ffn2_out):
    B, S, D = x.shape
    rows = S // GRID_W
    t = jnp.arange(S)
    row = jnp.repeat(jnp.arange(rows), GRID_W)
    col = jnp.tile(jnp.arange(GRID_W), rows)
    pos_cs = _rope_tables(t, MLA_ROPE_DIM)
    row_cs = _rope_tables(row, GQA_HEAD_DIM // 2)
    col_cs = _rope_tables(col, GQA_HEAD_DIM // 2)
    c_act = jax.nn.silu(c)

    h = x
    for l in range(DEPTH):
        mod = (c_act @ w_ada[l] + b_ada[l]).reshape(B, N_MOD, 1, D)
        sh1, sc1, g1, sh2, sc2, g2, sh3, sc3, g3 = [mod[:, i] for i in range(N_MOD)]

        u = _modulate(_rmsnorm(h, norm_ffn1[l]), sh1, sc1)
        h = h + 0.5 * g1 * _swiglu(u, w_ffn1_in[l], w_ffn1_out[l])

        u = _modulate(_rmsnorm(h, norm_mix[l]), sh2, sc2)
        z_q, z_kv, z_kr, z_gq, z_gk, z_gv, z_gate = _split_cols(u @ w_in[l], IN_SIZES)
        o_mla = _mla(z_q, z_kv, z_kr, mla_q_a_norm[l], mla_w_uq[l], mla_kv_a_norm[l], mla_w_ukv[l],
                     mla_qk_q_norm[l], mla_qk_k_norm[l], pos_cs)
        o_gqa = _gqa_axial(z_gq, z_gk, z_gv, gqa_q_norm[l], gqa_k_norm[l], row_cs, col_cs)
        gate_mla, gate_gqa = jnp.split(jax.nn.sigmoid(z_gate), N_BRANCHES, axis=-1)
        merged = gate_mla * (o_mla @ w_branch_mla[l]) + gate_gqa * (o_gqa @ w_branch_gqa[l])
        h = h + g2 * (merged @ w_out[l])

        u = _modulate(_rmsnorm(h, norm_ffn2[l]), sh3, sc3)
        h = h + 0.5 * g3 * _swiglu(u, w_ffn2_in[l], w_ffn2_out[l])
    return h
```

```cpp
#include <hip/hip_runtime.h>
#include <hip/hip_cooperative_groups.h>
#include <cstdio>
#include <cstdint>
namespace cg = cooperative_groups;

namespace pg8 {
#define PG8_LAS __attribute__((address_space(3)))
#define PG8_GAS __attribute__((address_space(1)))
typedef unsigned short bf16_t;
typedef short bf16x8 __attribute__((ext_vector_type(8)));
typedef float f32x4 __attribute__((ext_vector_type(4)));
typedef unsigned u32x4 __attribute__((ext_vector_type(4)));
constexpr int BM = 256, BK = 64, HALF = 128, HTB = HALF * BK * 2  , STAGE_BYTES = 8 * HTB, NXCD = 8, WGM = 8;

__host__ __device__ __forceinline__ int lds_byte(int r, int c) { const int st = (r >> 4) * 2 + (c >> 5), rr = r & 15, cc = c & 31, ob = rr * 64 + cc * 2; return st * 1024 + (ob ^ (((ob >> 9) & 1) << 5)); }
__host__ __device__ __forceinline__ void stage_rc(int b, int& R, int& C) { const int st = b / 1024, sb = b % 1024, swz = sb ^ (((sb >> 9) & 1) << 5); R = (st >> 1) * 16 + swz / 64; C = (st & 1) * 32 + (swz % 64) / 2; }
__host__ __device__ __forceinline__ int perm32(int rho) { const int n = rho >> 4, i = rho & 15; return 8 * (i >> 2) + 4 * n + (i & 3); }

struct Unit { int pm, pn; };
struct Gemm { const bf16_t* A; const bf16_t* Bt; int M, N, K, lda; };

struct StaticOrder {
    int nM, nN, nwg, G, c, rev;
    __host__ __device__ void init(int M, int N, int G_, int c_, int rev_ = 0) { nM = M / BM; nN = N / BM; nwg = nM * nN; G = G_; c = c_; rev = rev_; }
    __host__ __device__ bool next(int i, Unit& u) const {
        const long L = (long)i * G + c; if (L >= nwg) return false;
        int wgid = rev ? (nwg - 1 - (int)L) : (int)L; { const int q = nwg / NXCD, r = nwg % NXCD, xcd = wgid % NXCD, off = wgid / NXCD; wgid = (xcd < r ? xcd * (q + 1) : r * (q + 1) + (xcd - r) * q) + off; }
        const int nig = WGM * nN, gid = wgid / nig, fm = gid * WGM, gsz = (nM - fm) < WGM ? (nM - fm) : WGM;
        u.pm = fm + ((wgid % nig) % gsz); u.pn = (wgid % nig) / gsz; return true;
    }
    __device__ __forceinline__ void a_ready(const Unit&) const {}
    __device__ __forceinline__ void done(const Unit&) const {}
};

struct XcdOrder {
    int nN, q, r, nx, rev, pm0;
    __device__ void init(int pm0_, int LP, int N, int r_, int nx_, int rev_) { nN = N / BM; q = LP * nN; pm0 = pm0_; r = r_; nx = nx_; rev = rev_; }
    __device__ bool next(int i, Unit& u) const {
        int off = i * nx + r; if (off >= q) return false;
        if (rev) off = q - 1 - off;
        const int nig = WGM * nN, gid = off / nig, rem = off % nig;
        u.pn = rem / WGM; u.pm = pm0 + gid * WGM + rem % WGM; return true;
    }
    __device__ __forceinline__ void a_ready(const Unit&) const {}
    __device__ __forceinline__ void done(const Unit&) const {}
};

typedef float f32x2_ __attribute__((ext_vector_type(2))); typedef __bf16 bf16x2_ __attribute__((ext_vector_type(2)));
__device__ __forceinline__ unsigned cvt_pk_bf16(float lo, float hi) { const f32x2_ v = {lo, hi}; const bf16x2_ b = __builtin_convertvector(v, bf16x2_); return __builtin_bit_cast(unsigned, b); }
__device__ __forceinline__ float bf_lo(unsigned w) { return __uint_as_float(w << 16); }
__device__ __forceinline__ float bf_hi(unsigned w) { return __uint_as_float(w & 0xffff0000u); }
__device__ __forceinline__ float sigmoidf_(float x) { return __builtin_amdgcn_rcpf(1.0f + __builtin_amdgcn_exp2f(x * -1.4426950408889634f)); }

template <int MODE> struct EpiB {
    static constexpr bool PERM = true, AFTER_DRAIN = false;
    bf16_t* O; int ldc; bf16_t* O2; bf16_t* O3; const bf16_t* Gt; const float* rs; int add;
    __device__ __forceinline__ void operator()(const f32x4 (&acc)[2][2][4][2], const Unit& u, int wr, int wc, int fr, int fq) const {
        const int row0 = u.pm * BM + wr * 64 + fr;
        if constexpr (MODE == 0) {
            const int col0 = u.pn * HALF + wc * 32 + 8 * fq;
#pragma unroll
            for (int ai = 0; ai < 2; ++ai)
#pragma unroll
                for (int m = 0; m < 4; ++m) {
                    bf16_t* rowp = O + (size_t)(row0 + ai * HALF + m * 16) * ldc + col0;
                    const f32x4 a0 = acc[ai][0][m][0], a1 = acc[ai][0][m][1], b0 = acc[ai][1][m][0], b1 = acc[ai][1][m][1];
                    const float av[8] = {a0[0], a0[1], a0[2], a0[3], a1[0], a1[1], a1[2], a1[3]}, bv[8] = {b0[0], b0[1], b0[2], b0[3], b1[0], b1[1], b1[2], b1[3]};
                    float e[8], o[8];
#pragma unroll
                    for (int j = 0; j < 8; ++j) e[j] = __builtin_amdgcn_exp2f(-av[j]);
#pragma unroll
                    for (int j = 0; j < 8; ++j) e[j] = 1.0f + e[j];
#pragma unroll
                    for (int j = 0; j < 8; ++j) e[j] = __builtin_amdgcn_rcpf(e[j]);
#pragma unroll
                    for (int j = 0; j < 8; ++j) o[j] = (av[j] * bv[j]) * e[j];
                    u32x4 w; w.x = cvt_pk_bf16(o[0], o[1]); w.y = cvt_pk_bf16(o[2], o[3]); w.z = cvt_pk_bf16(o[4], o[5]); w.w = cvt_pk_bf16(o[6], o[7]);
                    *(PG8_GAS u32x4*)rowp = w;
                }
        } else {
            bf16_t* base = O; int ld = ldc; int colt = u.pn * BM;
            if constexpr (MODE == 1) { if (u.pn >= 11) { base = O3; ld = 768; colt = (u.pn - 11) * BM; } else if (u.pn >= 8) { base = O2; ld = 768; colt = (u.pn - 8) * BM; } }
            const int col0 = colt + wc * 32 + 8 * fq;
#pragma unroll
            for (int ai = 0; ai < 2; ++ai)
#pragma unroll
                for (int m = 0; m < 4; ++m) {
                    const int row = row0 + ai * HALF + m * 16;
                    float rsc = 1.f; if constexpr (MODE == 2) rsc = *(const PG8_GAS float*)(rs + row);
#pragma unroll
                    for (int bj = 0; bj < 2; ++bj) {
                        bf16_t* p = base + (size_t)row * ld + col0 + bj * HALF;
                        f32x4 v0 = acc[ai][bj][m][0], v1 = acc[ai][bj][m][1];
                        if constexpr (MODE == 2) { v0 = v0 * rsc; v1 = v1 * rsc; }
                        if constexpr (MODE == 3) {
                            const u32x4 g = *(const PG8_GAS u32x4*)(Gt + (size_t)row * 2048 + (add ? 1024 : 0) + col0 + bj * HALF);
                            float e[8] = {bf_lo(g.x), bf_hi(g.x), bf_lo(g.y), bf_hi(g.y), bf_lo(g.z), bf_hi(g.z), bf_lo(g.w), bf_hi(g.w)};
#pragma unroll
                            for (int j = 0; j < 8; ++j) e[j] = __builtin_amdgcn_exp2f(-e[j]);
#pragma unroll
                            for (int j = 0; j < 8; ++j) e[j] = 1.0f + e[j];
#pragma unroll
                            for (int j = 0; j < 8; ++j) e[j] = __builtin_amdgcn_rcpf(e[j]);
                            v0[0] *= e[0]; v0[1] *= e[1]; v0[2] *= e[2]; v0[3] *= e[3]; v1[0] *= e[4]; v1[1] *= e[5]; v1[2] *= e[6]; v1[3] *= e[7];
                        }
                        if (MODE == 3 && add) {
                            const u32x4 q = *(const PG8_GAS u32x4*)p;
                            v0[0] += bf_lo(q.x); v0[1] += bf_hi(q.x); v0[2] += bf_lo(q.y); v0[3] += bf_hi(q.y);
                            v1[0] += bf_lo(q.z); v1[1] += bf_hi(q.z); v1[2] += bf_lo(q.w); v1[3] += bf_hi(q.w);
                        }
                        u32x4 w; w.x = cvt_pk_bf16(v0[0], v0[1]); w.y = cvt_pk_bf16(v0[2], v0[3]); w.z = cvt_pk_bf16(v1[0], v1[1]); w.w = cvt_pk_bf16(v1[2], v1[3]);
                        *(PG8_GAS u32x4*)p = w;
                    }
                }
        }
    }
};
struct EpiRes {
    static constexpr bool PERM = false, AFTER_DRAIN = false;
    const void* base; void* out; const float* gate; float coef; int row_off; int in_bf, out_bf;
    __device__ __forceinline__ void operator()(const f32x4 (&acc)[2][2][4][2], const Unit& u, int wr, int wc, int fr, int fq) const {
        typedef unsigned u32x2 __attribute__((ext_vector_type(2)));
        const int b = (u.pm * BM + row_off) >> 11;
        const int col0 = u.pn * BM + wc * 32 + 4 * fq;
        f32x4 gv[2][2];
#pragma unroll
        for (int bj = 0; bj < 2; ++bj)
#pragma unroll
            for (int n = 0; n < 2; ++n) gv[bj][n] = *(const PG8_GAS f32x4*)(gate + (size_t)b * 9216 + col0 + bj * HALF + n * 16) * coef;
#pragma unroll
        for (int ai = 0; ai < 2; ++ai)
#pragma unroll
            for (int m = 0; m < 4; ++m) {
                const size_t off = (size_t)(u.pm * BM + ai * HALF + wr * 64 + m * 16 + fr) * 1024 + col0;
#pragma unroll
                for (int bj = 0; bj < 2; ++bj)
#pragma unroll
                    for (int n = 0; n < 2; ++n) {
                        const size_t o = off + bj * HALF + n * 16;
                        f32x4 bs;
                        if (in_bf) { const u32x2 w = *(const PG8_GAS u32x2*)((const bf16_t*)base + o); bs = (f32x4){bf_lo(w.x), bf_hi(w.x), bf_lo(w.y), bf_hi(w.y)}; }
                        else bs = *(const PG8_GAS f32x4*)((const float*)base + o);
                        const f32x4 r = bs + gv[bj][n] * acc[ai][bj][m][n];
                        if (out_bf) { u32x2 w; w.x = cvt_pk_bf16(r[0], r[1]); w.y = cvt_pk_bf16(r[2], r[3]); *(PG8_GAS u32x2*)((bf16_t*)out + o) = w; }
                        else *(PG8_GAS f32x4*)((float*)out + o) = r;
                    }
            }
    }
};

template <class Epi, class Sched, bool ALIGN_EPI = false, bool SP2 = false>
__device__ __forceinline__ void gemm_phase(PG8_LAS unsigned char* lds, const Gemm g, const Sched& S, const Epi& E, const int tid) {
    const int wid = __builtin_amdgcn_readfirstlane(tid >> 6), lane = tid & 63, wr = wid >> 2, wc = wid & 3, fr = lane & 15, fq = lane >> 4;
    const int K = g.K, lda = g.lda, nt = K / BK;
    unsigned voffA[2], voffB[2];
#pragma unroll
    for (int i = 0; i < 2; ++i) { int R, C; stage_rc(tid * 16 + i * 8192, R, C); const int Rb = Epi::PERM ? ((R & ~31) + perm32(R & 31)) : R;
        voffA[i] = (unsigned)(R * lda + C) * 2u; voffB[i] = (unsigned)(Rb * K + C) * 2u; }
    const size_t kstep = (size_t)(BK * 2);
    const size_t hstepA = (size_t)HALF * lda * 2, hstepB = (size_t)HALF * K * 2;
    const size_t tstepA = 2 * hstepA, tstepB = 2 * hstepB;
    const unsigned ldsw = (unsigned)wid * 1024u;
    const int aoff = lds_byte(wr * 64 + fr, fq * 8), boff = lds_byte(wc * 32 + fr, fq * 8);
#define PG8_SA(b, h) (((b) * 2 + (h)) * HTB)
#define PG8_SB(b, h) ((4 + (b) * 2 + (h)) * HTB)
#define PG8_STAGE(bufoff, gbase, voff) do { _Pragma("unroll") for (int _i = 0; _i < 2; ++_i) \
        __builtin_amdgcn_global_load_lds((const unsigned*)((const char*)(gbase) + (voff)[_i]), (PG8_LAS unsigned*)(lds + (bufoff) + ldsw + _i * 8192), 16, 0, 0); } while (0)
#define PG8_LDA(dst, b, h) do { _Pragma("unroll") for (int m = 0; m < 4; ++m) _Pragma("unroll") for (int k = 0; k < 2; ++k) dst[m][k] = *(const PG8_LAS bf16x8*)(lds + PG8_SA(b, h) + aoff + m * 2048 + k * 1024); } while (0)
#define PG8_LDB(dst, b, h) do { _Pragma("unroll") for (int n = 0; n < 2; ++n) _Pragma("unroll") for (int k = 0; k < 2; ++k) dst[n][k] = *(const PG8_LAS bf16x8*)(lds + PG8_SB(b, h) + boff + n * 2048 + k * 1024); } while (0)
#define PG8_MMA(ai, bj, At, Bt) do { __builtin_amdgcn_s_setprio(1); _Pragma("unroll") for (int m = 0; m < 4; ++m) _Pragma("unroll") for (int n = 0; n < 2; ++n) _Pragma("unroll") for (int k = 0; k < 2; ++k) \
        acc[ai][bj][m][n] = __builtin_amdgcn_mfma_f32_16x16x32_bf16(Bt[n][k], At[m][k], acc[ai][bj][m][n], 0, 0, 0); __builtin_amdgcn_s_setprio(0); } while (0)
#define PG8_WAIT_V(n) asm volatile("s_waitcnt vmcnt(" #n ")" ::: "memory")
#define PG8_WAIT_L(n) asm volatile("s_waitcnt lgkmcnt(" #n ")" ::: "memory")
#define PG8_BAR __builtin_amdgcn_s_barrier()
#define PG8_SCHED __builtin_amdgcn_sched_barrier(0)
    Unit cur, nxt; int ui = 0;
    if (!S.next(0, cur)) return;
    f32x4 acc[2][2][4][2];
#pragma unroll
    for (int a = 0; a < 2; ++a)
#pragma unroll
        for (int b = 0; b < 2; ++b)
#pragma unroll
            for (int m = 0; m < 4; ++m)
#pragma unroll
                for (int n = 0; n < 2; ++n) acc[a][b][m][n] = (f32x4){0.f, 0.f, 0.f, 0.f};
    bf16x8 At[4][2], B0[2][2], B1[2][2];
    const char* cA = (const char*)g.A + (size_t)cur.pm * tstepA; const char* cB = (const char*)g.Bt + (size_t)cur.pn * tstepB;
    S.a_ready(cur);
    if constexpr (SP2) {
        PG8_STAGE(PG8_SB(0, 0), cB, voffB); PG8_STAGE(PG8_SB(0, 1), cB + hstepB, voffB); PG8_STAGE(PG8_SA(0, 0), cA, voffA); PG8_STAGE(PG8_SA(0, 1), cA + hstepA, voffA);
        if (wr == 1) PG8_BAR;
        PG8_WAIT_V(2); PG8_BAR;
        PG8_STAGE(PG8_SB(1, 0), cB + kstep, voffB); PG8_STAGE(PG8_SA(1, 0), cA + kstep, voffA); PG8_STAGE(PG8_SB(1, 1), cB + hstepB + kstep, voffB);
        PG8_WAIT_V(6); PG8_BAR;
    } else {
        PG8_STAGE(PG8_SB(0, 0), cB, voffB); PG8_STAGE(PG8_SA(0, 0), cA, voffA); PG8_STAGE(PG8_SB(0, 1), cB + hstepB, voffB); PG8_STAGE(PG8_SA(0, 1), cA + hstepA, voffA);
        if (wr == 1) PG8_BAR;
        PG8_WAIT_V(4); PG8_BAR;
        PG8_STAGE(PG8_SB(1, 0), cB + kstep, voffB); PG8_STAGE(PG8_SA(1, 0), cA + kstep, voffA); PG8_STAGE(PG8_SB(1, 1), cB + hstepB + kstep, voffB);
        PG8_WAIT_V(6); PG8_BAR;
    }
    for (;;) {
        const bool has_next = S.next(ui + 1, nxt);
        const char* nA = has_next ? (const char*)g.A + (size_t)nxt.pm * tstepA : cA; const char* nB = has_next ? (const char*)g.Bt + (size_t)nxt.pn * tstepB : cB;
        for (int t = 0; t < nt; t += 2) {
            const bool last = (t == nt - 2);
            const char* a1 = cA + (size_t)(t + 1) * kstep;
            const char* a2 = last ? nA : cA + (size_t)(t + 2) * kstep; const char* b2 = last ? nB : cB + (size_t)(t + 2) * kstep;
            const char* a3 = a2 + kstep; const char* b3 = b2 + kstep;
            if (last && has_next) S.a_ready(nxt);
            if constexpr (SP2) {
            PG8_LDB(B0, 0, 0); PG8_LDB(B1, 0, 1); PG8_SCHED; PG8_LDA(At, 0, 0); PG8_STAGE(PG8_SA(1, 1), a1 + hstepA, voffA);
            PG8_WAIT_V(8); PG8_WAIT_L(0); PG8_BAR; PG8_MMA(0, 0, At, B0); PG8_MMA(0, 1, At, B1); PG8_BAR; PG8_SCHED;
            PG8_LDA(At, 0, 1); PG8_STAGE(PG8_SB(0, 0), b2, voffB); PG8_STAGE(PG8_SB(0, 1), b2 + hstepB, voffB); PG8_STAGE(PG8_SA(0, 0), a2, voffA);
            PG8_WAIT_V(8); PG8_WAIT_L(0); PG8_BAR; PG8_MMA(1, 0, At, B0); PG8_MMA(1, 1, At, B1); PG8_BAR; PG8_SCHED;
            PG8_LDB(B0, 1, 0); PG8_LDB(B1, 1, 1); PG8_SCHED; PG8_LDA(At, 1, 0); PG8_STAGE(PG8_SA(0, 1), a2 + hstepA, voffA);
            PG8_WAIT_V(8); PG8_WAIT_L(0); PG8_BAR; PG8_MMA(0, 0, At, B0); PG8_MMA(0, 1, At, B1); PG8_BAR; PG8_SCHED;
            PG8_LDA(At, 1, 1); PG8_STAGE(PG8_SB(1, 0), b3, voffB); PG8_STAGE(PG8_SB(1, 1), b3 + hstepB, voffB); PG8_STAGE(PG8_SA(1, 0), a3, voffA);
            PG8_WAIT_V(8); PG8_WAIT_L(0); PG8_BAR; PG8_MMA(1, 0, At, B0); PG8_MMA(1, 1, At, B1); PG8_BAR; PG8_SCHED;
            } else {
            PG8_LDB(B0, 0, 0); PG8_SCHED; PG8_LDA(At, 0, 0); PG8_STAGE(PG8_SA(1, 1), a1 + hstepA, voffA);
            PG8_WAIT_L(8); PG8_BAR; PG8_WAIT_L(0); PG8_MMA(0, 0, At, B0); PG8_BAR; PG8_SCHED;
            PG8_LDB(B1, 0, 1); PG8_STAGE(PG8_SB(0, 0), b2, voffB);
            PG8_BAR; PG8_WAIT_L(0); PG8_MMA(0, 1, At, B1); PG8_BAR;
            PG8_LDA(At, 0, 1); PG8_STAGE(PG8_SA(0, 0), a2, voffA);
            PG8_BAR; PG8_WAIT_L(0); PG8_MMA(1, 0, At, B0); PG8_BAR; PG8_SCHED;
            PG8_STAGE(PG8_SB(0, 1), b2 + hstepB, voffB);
            PG8_WAIT_V(6); PG8_BAR; PG8_MMA(1, 1, At, B1); PG8_BAR;
            PG8_LDB(B0, 1, 0); PG8_SCHED; PG8_LDA(At, 1, 0); PG8_STAGE(PG8_SA(0, 1), a2 + hstepA, voffA);
            PG8_WAIT_L(8); PG8_BAR; PG8_WAIT_L(0); PG8_MMA(0, 0, At, B0); PG8_BAR; PG8_SCHED;
            PG8_LDB(B1, 1, 1); PG8_STAGE(PG8_SB(1, 0), b3, voffB);
            PG8_BAR; PG8_WAIT_L(0); PG8_MMA(0, 1, At, B1); PG8_BAR;
            PG8_LDA(At, 1, 1); PG8_STAGE(PG8_SA(1, 0), a3, voffA);
            PG8_BAR; PG8_WAIT_L(0); PG8_MMA(1, 0, At, B0); PG8_BAR; PG8_SCHED;
            PG8_STAGE(PG8_SB(1, 1), b3 + hstepB, voffB);
            PG8_WAIT_V(6); PG8_BAR; PG8_MMA(1, 1, At, B1); PG8_BAR;
            }
        }
        if constexpr (ALIGN_EPI) { if (wr == 0) PG8_BAR; }
        if constexpr (!Epi::AFTER_DRAIN) { E(acc, cur, wr, wc, fr, fq); S.done(cur); }
        if (!has_next) break;
#pragma unroll
        for (int a = 0; a < 2; ++a)
#pragma unroll
            for (int b = 0; b < 2; ++b)
#pragma unroll
                for (int m = 0; m < 4; ++m)
#pragma unroll
                    for (int n = 0; n < 2; ++n) acc[a][b][m][n] = (f32x4){0.f, 0.f, 0.f, 0.f};
        cur = nxt; cA = nA; cB = nB; ++ui;
        if constexpr (ALIGN_EPI) { if (wr == 1) PG8_BAR; }
    }
    PG8_WAIT_V(0);
    if constexpr (!ALIGN_EPI) { if (wr == 0) PG8_BAR; }
    PG8_BAR;
    if constexpr (Epi::AFTER_DRAIN) { E.fused(acc, cur, wr, wc, fr, fq, lds, wid, lane); S.done(cur); }
#undef PG8_SA
#undef PG8_SB
#undef PG8_STAGE
#undef PG8_LDA
#undef PG8_LDB
#undef PG8_MMA
#undef PG8_WAIT_V
#undef PG8_WAIT_L
#undef PG8_BAR
#undef PG8_SCHED
}
}

#define LAS __attribute__((address_space(3)))
#define GASP __attribute__((address_space(1)))
typedef unsigned short bf16;
typedef unsigned v4u __attribute__((ext_vector_type(4)));
typedef unsigned v2u __attribute__((ext_vector_type(2)));
typedef float f32x2 __attribute__((ext_vector_type(2)));
typedef float f32x4 __attribute__((ext_vector_type(4)));
typedef float f32x16 __attribute__((ext_vector_type(16)));
typedef short bf16x8 __attribute__((ext_vector_type(8)));

constexpr int NWAVES = 8, NTHR = 512;
constexpr int BATCH = 32, SEQ = 2048, DM = 1024, DEPTH = 2, TOK = BATCH * SEQ, FF = 2816, NMODC = 9216;
constexpr int TH = TOK / 2;
constexpr float EPS = 1e-6f;
constexpr float QS_G = 0.125f * 1.4426950408889634f;
constexpr float QS_M = 0.10206207261596575f * 1.4426950408889634f;
constexpr int LDS_BYTES = 147456;

constexpr size_t MiB = 1u << 20;
constexpr size_t WS_MOD = 0, WS_CS = 3 * MiB, WS_RSQ = WS_CS + 262144, WS_RSKV = WS_RSQ + 131072;
constexpr size_t WS_BAR = WS_RSKV + 131072;
constexpr size_t WS_WT = 4 * MiB, WS_U = 100 * MiB, WS_X = 228 * MiB;
constexpr size_t WS_HID = WS_X;
constexpr size_t ARENA = (size_t)8192 * FF * 2, AR_G = 0, AR_ZG = 16 * MiB, AR_ZM = 22 * MiB, AR_QRAW = 28 * MiB, AR_KVRAW = 34 * MiB;
static_assert(AR_KVRAW + (size_t)4096 * 1024 * 2 <= ARENA && 8 * ARENA == (size_t)TOK * FF * 2, "arena map");
constexpr size_t WS_Y = 580 * MiB;
constexpr size_t WS_QG = WS_Y, WS_KG = WS_Y + 32 * MiB, WS_VTG = WS_Y + 40 * MiB, WS_QM = WS_Y + 48 * MiB, WS_KM = WS_Y + 96 * MiB, WS_VTM = WS_Y + 144 * MiB,
                 WS_OM = WS_Y + 176 * MiB, WS_OG = WS_Y + 208 * MiB, WS_MG = WS_Y + 240 * MiB, WS_H = WS_Y + 304 * MiB  , WS_END = WS_Y + 432 * MiB;
static_assert(WS_HID + (size_t)TOK * FF * 2 <= WS_Y, "ws map");
constexpr size_t LW = 23625728;
static_assert(WS_WT + 2 * LW * 2 <= WS_U, "weights fit");

struct Frame {
    LAS unsigned char* lds;
    int tid, lane, wave, vcu, G, bx;
    int xid, xr, nx;
};

__device__ __forceinline__ float wave_sum(float v) {
#pragma unroll
    for (int o = 1; o < 64; o <<= 1) v += __shfl_xor(v, o);
    return v;
}
template <class T> __device__ __forceinline__ T* uni(T* p) {
    const unsigned long long v = (unsigned long long)p;
    const unsigned lo = __builtin_amdgcn_readfirstlane((unsigned)v), hi = __builtin_amdgcn_readfirstlane((unsigned)(v >> 32));
    return (T*)(((unsigned long long)hi << 32) | lo);
}
__device__ __forceinline__ float bf2f(bf16 v) { return __uint_as_float((unsigned)v << 16); }
__device__ __forceinline__ unsigned f2bf(float f) { unsigned u = __float_as_uint(f); return (u + 0x7fffu + ((u >> 16) & 1u)) >> 16; }
__device__ __forceinline__ unsigned pk2(float lo, float hi) { return f2bf(lo) | (f2bf(hi) << 16); }

__device__ __forceinline__ void mat_info(int mat, int& K, int& Nd, int& Ns, size_t& off, int& in_idx, int& gain_idx) {
    gain_idx = -1;
    switch (mat) {
        case 0: K = 1024; Nd = 5632; Ns = 5632; off = 0; in_idx = 5; break;
        case 1: K = 2816; Nd = 1024; Ns = 1024; off = 5767168; in_idx = 6; break;
        case 2: K = 1024; Nd = 3584; Ns = 3488; off = 8650752; in_idx = 8; break;
        case 3: K = 384; Nd = 768; Ns = 768; off = 12320768; in_idx = 10; gain_idx = 9; break;
        case 4: K = 256; Nd = 1024; Ns = 1024; off = 12615680; in_idx = 12; gain_idx = 11; break;
        case 5: K = 512; Nd = 1024; Ns = 1024; off = 12877824; in_idx = 17; break;
        case 6: K = 512; Nd = 1024; Ns = 1024; off = 13402112; in_idx = 18; break;
        case 7: K = 1024; Nd = 1024; Ns = 1024; off = 13926400; in_idx = 19; break;
        case 8: K = 1024; Nd = 5632; Ns = 5632; off = 14974976; in_idx = 21; break;
        default: K = 2816; Nd = 1024; Ns = 1024; off = 20742144; in_idx = 22; break;
    }
}
__device__ __forceinline__ int mat_items(int mat) {
    switch (mat) { case 0: case 8: return 2816; case 1: case 9: return 1408; case 2: return 1792; case 3: return 144; case 4: return 128; case 5: case 6: return 256; default: return 512; }
}
constexpr int ITEMS_PER_LAYER = 2816 + 1408 + 1792 + 144 + 128 + 256 + 256 + 512 + 2816 + 1408;

__device__ __forceinline__ void cvt_item(const float* W, int K, int Ns, int src0, const float* gain, float cscale, bf16* WT, int n0, int k0, LAS float* scr, int lane) {
    float v_[32];
#pragma unroll
    for (int i = 0; i < 32; ++i) {
        const int kk = 2 * i + (lane >> 5);
        v_[i] = 0.f;
        if (src0 >= 0) v_[i] = W[(size_t)(k0 + kk) * Ns + src0 + (lane & 31)];
    }
#pragma unroll
    for (int i = 0; i < 32; ++i) {
        const int kk = 2 * i + (lane >> 5);
        float v = v_[i] * cscale;
        if (gain) v *= gain[k0 + kk];
        scr[kk * 33 + (lane & 31)] = v;
    }
    asm volatile("s_waitcnt lgkmcnt(0)" ::: "memory");
    const int c = lane & 7;
#pragma unroll
    for (int j = 0; j < 4; ++j) {
        const int n = (lane >> 3) + 8 * j; const LAS float* s = scr + (8 * c) * 33 + n;
        v4u o; o.x = pk2(s[0 * 33], s[1 * 33]); o.y = pk2(s[2 * 33], s[3 * 33]); o.z = pk2(s[4 * 33], s[5 * 33]); o.w = pk2(s[6 * 33], s[7 * 33]);
        *(v4u*)(WT + (size_t)(n0 + n) * K + k0 + 8 * c) = o;
    }
    asm volatile("s_waitcnt lgkmcnt(0)" ::: "memory");
}

struct Args { const float* in[23]; float* out; unsigned char* ws; int pad[2]; };
__device__ __forceinline__ const float* in_sel(const Args& a, int idx) {
    switch (idx) {
        case 5: return uni(a.in[5]); case 6: return uni(a.in[6]); case 8: return uni(a.in[8]); case 9: return uni(a.in[9]); case 10: return uni(a.in[10]); case 11: return uni(a.in[11]); case 12: return uni(a.in[12]);
        case 17: return uni(a.in[17]); case 18: return uni(a.in[18]); case 19: return uni(a.in[19]); case 21: return uni(a.in[21]); default: return uni(a.in[22]);
    }
}
__device__ __forceinline__ void p0_prologue(Frame& F, const Args& A, unsigned char* ws) {
    LAS float* scr = (LAS float*)(F.lds + F.wave * 16384);
    const int gw = F.vcu * NWAVES + F.wave, NGW = F.G * NWAVES;
    bf16* WT = (bf16*)(ws + WS_WT);
    for (int it = gw; it < DEPTH * ITEMS_PER_LAYER; it += NGW) {
        const int l = it / ITEMS_PER_LAYER; int r = it % ITEMS_PER_LAYER; int mat = 0;
        for (;;) { const int n = mat_items(mat); if (r < n) break; r -= n; ++mat; }
        int K, Nd, Ns, in_idx, gain_idx; size_t off; mat_info(mat, K, Nd, Ns, off, in_idx, gain_idx);
        const int nblk = Nd / 32, kb = r / nblk, nb = r % nblk, n0 = nb * 32, k0 = kb * 64;
        int src0 = n0; float cscale = 1.0f;
        if (mat == 0 || mat == 8) { const int pn = n0 >> 8, rr = n0 & 255, bj = rr >> 7, cc = rr & 127; src0 = bj * FF + 128 * pn + cc; cscale = bj == 0 ? 1.4426950408889634f : 0.6931471805599453f; }
        else if (mat == 2) { src0 = (n0 < 2048) ? 1440 + n0 : (n0 < 2816) ? 672 + (n0 - 2048) : (n0 < 3488) ? (n0 - 2816) : -1; if (n0 < 2048) cscale = 1.4426950408889634f; }
        const float* W = in_sel(A, in_idx) + (size_t)l * K * Ns;
        const float* gain = gain_idx >= 0 ? in_sel(A, gain_idx) + (size_t)l * K : nullptr;
        cvt_item(W, K, Ns, src0, gain, cscale, WT + (size_t)l * LW + off, n0, k0, scr, F.lane);
    }
    {
        f32x2* CS = (f32x2*)(ws + WS_CS);
        for (int idx = (F.vcu * NTHR + F.tid); idx < 2048 * 16; idx += F.G * NTHR) {
            const int pos = idx >> 4, i = idx & 15;
            const float inv = exp2f(-(float)i * (13.287712379549449f / 16.0f));
            const float ang = (float)pos * inv;
            const double rev = (double)ang * 0.15915494309189535;
            const float fr = (float)(rev - __builtin_rint(rev));
            CS[idx] = (f32x2){__builtin_amdgcn_cosf(fr), __builtin_amdgcn_sinf(fr)};
        }
    }
    __syncthreads();
    {
        LAS float* cs = (LAS float*)F.lds;
        const float* c = uni(A.in[1]);
        float* mod = (float*)(ws + WS_MOD);
        for (int it = F.vcu; it < DEPTH * (NMODC / 64); it += F.G) {
            for (int idx = F.tid; idx < 32 * 1024; idx += NTHR) { const int k = idx >> 5, b = idx & 31; const float v = c[b * 1024 + k]; cs[idx] = v / (1.0f + __expf(-v)); }
            __syncthreads();
            const int l = it / (NMODC / 64), jb = it % (NMODC / 64), col = jb * 64 + F.lane;
            const float* w = uni(A.in[2]) + (size_t)l * 1024 * NMODC + col;
            float acc[32];
#pragma unroll
            for (int b = 0; b < 32; ++b) acc[b] = 0.f;
            const int kbeg = F.wave * 128;
#pragma unroll 4
            for (int k = kbeg; k < kbeg + 128; ++k) {
                const float wv = w[(size_t)k * NMODC];
                const LAS f32x4* cr = (const LAS f32x4*)(cs + k * 32);
#pragma unroll
                for (int b4 = 0; b4 < 8; ++b4) { const f32x4 cv = cr[b4]; acc[4 * b4] += cv[0] * wv; acc[4 * b4 + 1] += cv[1] * wv; acc[4 * b4 + 2] += cv[2] * wv; acc[4 * b4 + 3] += cv[3] * wv; }
            }
            __syncthreads();
            LAS float* red = (LAS float*)F.lds;
#pragma unroll
            for (int b = 0; b < 32; ++b) red[(F.wave * 32 + b) * 64 + F.lane] = acc[b];
            __syncthreads();
#pragma unroll
            for (int q = 0; q < 4; ++q) {
                const int idx = F.tid + NTHR * q, b = idx >> 6, cc = idx & 63;
                float sum = uni(A.in[3])[(size_t)l * NMODC + jb * 64 + cc];
#pragma unroll
                for (int wv = 0; wv < 8; ++wv) sum += red[(wv * 32 + b) * 64 + cc];
                mod[((size_t)l * 32 + b) * NMODC + jb * 64 + cc] = sum;
            }
            __syncthreads();
        }
    }
}

template <int CTRL> __device__ __forceinline__ float dppf(float v) { return __builtin_bit_cast(float, __builtin_amdgcn_update_dpp(0, __builtin_bit_cast(int, v), CTRL, 0xF, 0xF, true)); }
__device__ __forceinline__ float row8_sum(float v) { v += dppf<0xB1>(v); v += dppf<0x4E>(v); v += dppf<0x141>(v); return v; }
__device__ __forceinline__ float row16_sum(float v) { v = row8_sum(v); v += dppf<0x140>(v); return v; }
__device__ __forceinline__ f32x4 ld4bf(const bf16* p) { const v2u w = *(const GASP v2u*)p; return (f32x4){__uint_as_float(w.x << 16), __uint_as_float(w.x & 0xffff0000u), __uint_as_float(w.y << 16), __uint_as_float(w.y & 0xffff0000u)}; }
__device__ __forceinline__ v2u pk4(f32x4 v) { v2u w; w.x = pk2(v[0], v[1]); w.y = pk2(v[2], v[3]); return w; }
__device__ __forceinline__ float dot4(f32x4 x) { return (x[0] * x[0] + x[1] * x[1]) + (x[2] * x[2] + x[3] * x[3]); }
__device__ __forceinline__ f32x4 rope4(f32x4 y, f32x4 cA, f32x4 cB, bool hi) {
    f32x4 p; p[0] = __shfl_xor(y[0], 4); p[1] = __shfl_xor(y[1], 4); p[2] = __shfl_xor(y[2], 4); p[3] = __shfl_xor(y[3], 4);
    if (!hi) p = -p;
    return (f32x4){y[0] * cA[0] + p[0] * cA[1], y[1] * cA[2] + p[1] * cA[3], y[2] * cB[0] + p[2] * cB[1], y[3] * cB[2] + p[3] * cB[3]};
}

__device__ __forceinline__ void norm_phase(Frame& F, const void* h, int h_bf, const float* gain, const float* sh, const float* sc, bf16* U) {
    const int lw = F.xr * NWAVES + F.wave, NLW = F.nx * NWAVES;
    for (int lb = lw; lb < 256; lb += NLW) {
        const int blk = 256 * F.xid + lb;
        const int m0 = blk * 32, b = m0 >> 11;
        f32x4 A[4], B[4];
#pragma unroll
        for (int j = 0; j < 4; ++j) {
            const int col = 256 * j + 4 * F.lane;
            A[j] = *(const GASP f32x4*)(gain + col) * (*(const GASP f32x4*)(sc + (size_t)b * NMODC + col) + 1.0f);
            B[j] = *(const GASP f32x4*)(sh + (size_t)b * NMODC + col);
        }
#pragma unroll 4
        for (int r = 0; r < 32; ++r) {
            const int m = m0 + r;
            f32x4 v[4]; float s = 0.f;
            if (h_bf) {
                const bf16* xr = (const bf16*)h + (size_t)m * DM + 4 * F.lane;
#pragma unroll
                for (int j = 0; j < 4; ++j) { v[j] = ld4bf(xr + 256 * j); s += dot4(v[j]); }
            } else {
                const f32x4* xr = (const f32x4*)((const float*)h + (size_t)m * DM) + F.lane;
#pragma unroll
                for (int j = 0; j < 4; ++j) { v[j] = *(const GASP f32x4*)(xr + 64 * j); s += dot4(v[j]); }
            }
            s = row16_sum(s); s += __shfl_xor(s, 16); s += __shfl_xor(s, 32);
            const float rstd = rsqrtf(s * (1.f / DM) + EPS);
            v2u* o8 = (v2u*)(U + (size_t)m * DM) + F.lane;
#pragma unroll
            for (int j = 0; j < 4; ++j) *(GASP v2u*)(o8 + 64 * j) = pk4(v[j] * rstd * A[j] + B[j]);
        }
    }
}

__device__ __forceinline__ void pp1_phase(Frame& F, unsigned char* ws, const bf16* ZG, const bf16* ZM, const float* gqn, const float* gkn) {
    float* RSQ = (float*)(ws + WS_RSQ); float* RSKV = (float*)(ws + WS_RSKV);
    bf16* QG = (bf16*)(ws + WS_QG); bf16* KG = (bf16*)(ws + WS_KG); bf16* VTG = (bf16*)(ws + WS_VTG);
    const float* CS = (const float*)(ws + WS_CS);
    const int lane = F.lane, a = lane & 15;
    const f32x4 gq4 = *(const GASP f32x4*)(gqn + 4 * a), gk4 = *(const GASP f32x4*)(gkn + 4 * a);
    const bool hi = (a & 4) != 0;
    LAS bf16* stage = (LAS bf16*)F.lds;
    for (int lc = F.xr; lc < 64; lc += F.nx) {
        const int ch = 64 * F.xid + lc;
        const int lr0 = ch * 64, bl = lr0 >> 11, s0 = lr0 & 2047;
#pragma unroll 2
        for (int i = 0; i < 8; ++i) {
            const int tk = F.wave * 8 + i, lr = lr0 + tk, s = s0 + tk;
            const bf16* zg = ZG + (size_t)lr * 768; const bf16* zm = ZM + (size_t)lr * 768;
            float ss = dot4(ld4bf(zm + 4 * lane)); if (lane < 32) ss += dot4(ld4bf(zm + 256 + 4 * lane));
            ss = wave_sum(ss); if (lane == 0) RSQ[lr] = rsqrtf(ss * (1.f / 384.f) + EPS);
            ss = wave_sum(dot4(ld4bf(zm + 384 + 4 * lane))); if (lane == 0) RSKV[lr] = rsqrtf(ss * (1.f / 256.f) + EPS);
            const int pos = (a < 8) ? (s >> 6) : (s & 63);
            const f32x4 cA = *(const GASP f32x4*)(CS + (pos * 16 + 4 * (a & 3)) * 2), cB = *(const GASP f32x4*)(CS + (pos * 16 + 4 * (a & 3)) * 2 + 4);
#pragma unroll
            for (int j = 0; j < 3; ++j) {
                const v2u raw = *(const GASP v2u*)(zg + 256 * j + 4 * lane);
                const f32x4 x = (f32x4){__uint_as_float(raw.x << 16), __uint_as_float(raw.x & 0xffff0000u), __uint_as_float(raw.y << 16), __uint_as_float(raw.y & 0xffff0000u)};
                const float q = row16_sum(dot4(x));
                const float r = rsqrtf(q * (1.f / 64.f) + EPS);
                const f32x4 o = rope4(x * r * (j < 2 ? gq4 : gk4), cA, cB, hi);
                if (j < 2) *(GASP v2u*)(QG + (size_t)lr * 512 + 256 * j + 4 * lane) = pk4(o * QS_G);
                else if (lane < 32) *(GASP v2u*)(KG + (size_t)lr * 128 + 4 * lane) = pk4(o);
                else *(LAS v2u*)(stage + tk * 132 + 4 * (lane - 32)) = raw;
            }
        }
        __syncthreads();
#pragma unroll
        for (int jj = 0; jj < 2; ++jj) {
            const int it = F.tid + 512 * jj, hd = it >> 3, cc = it & 7;
            unsigned e[8];
#pragma unroll
            for (int j = 0; j < 8; ++j) e[j] = stage[(8 * cc + j) * 132 + hd];
            v4u o; o.x = e[0] | (e[1] << 16); o.y = e[2] | (e[3] << 16); o.z = e[4] | (e[5] << 16); o.w = e[6] | (e[7] << 16);
            *(GASP v4u*)(VTG + ((size_t)(bl * 128 + hd)) * 2048 + s0 + 8 * cc) = o;
        }
        __syncthreads();
    }
}

__device__ __forceinline__ void pp2_phase(Frame& F, unsigned char* ws, const bf16* QRAW, const bf16* KVRAW, const bf16* ZM, const float* gqn, const float* gkn) {
    bf16* QM = (bf16*)(ws + WS_QM); bf16* KM = (bf16*)(ws + WS_KM); bf16* VTM = (bf16*)(ws + WS_VTM);
    const float* CS = (const float*)(ws + WS_CS);
    const int lane = F.lane, a = lane & 15, hh = lane >> 4, a8 = lane & 7, h8 = lane >> 3;
    const f32x4 g0q = *(const GASP f32x4*)(gqn + 4 * a), g1q = *(const GASP f32x4*)(gqn + 64 + 4 * a8), g0k = *(const GASP f32x4*)(gkn + 4 * a), g1k = *(const GASP f32x4*)(gkn + 64 + 4 * a8);
    const bool hi = (a8 & 4) != 0;
    LAS bf16* stage = (LAS bf16*)F.lds;
    for (int lc = F.xr; lc < 64; lc += F.nx) {
        const int ch = 64 * F.xid + lc;
        const int lr0 = ch * 64, bl = lr0 >> 11, s0 = lr0 & 2047;
#pragma unroll 2
        for (int i = 0; i < 8; ++i) {
            const int tk = F.wave * 8 + i, lr = lr0 + tk, s = s0 + tk;
            const bf16* qr = QRAW + (size_t)lr * 768; const bf16* kvr = KVRAW + (size_t)lr * 1024; const bf16* zm = ZM + (size_t)lr * 768;
            const f32x4 cA = *(const GASP f32x4*)(CS + (s * 16 + 4 * (a8 & 3)) * 2), cB = *(const GASP f32x4*)(CS + (s * 16 + 4 * (a8 & 3)) * 2 + 4);
            {
                const f32x4 xr = ld4bf(qr + 96 * h8 + 64 + 4 * a8);
                const float ssr = row8_sum(dot4(xr));
                float rp[2];
#pragma unroll
                for (int p = 0; p < 2; ++p) {
                    const f32x4 xn = ld4bf(qr + 96 * (4 * p + hh) + 4 * a);
                    const float ssn = row16_sum(dot4(xn));
                    const float ssrh = __shfl(ssr, 32 * p + 8 * hh);
                    const float r = rsqrtf((ssn + ssrh) * (1.f / 96.f) + EPS); rp[p] = r;
                    *(GASP v2u*)(QM + (size_t)lr * 768 + 96 * (4 * p + hh) + 4 * a) = pk4(xn * g0q * (r * QS_M));
                }
                const float r0 = __shfl(rp[0], 16 * (h8 & 3)), r1 = __shfl(rp[1], 16 * (h8 & 3));
                const float rr = (h8 < 4) ? r0 : r1;
                const f32x4 o = rope4(xr * g1q * rr, cA, cB, hi);
                *(GASP v2u*)(QM + (size_t)lr * 768 + 96 * h8 + 64 + 4 * a8) = pk4(o * QS_M);
            }
            {
                const f32x4 kr = ld4bf(zm + 640 + 4 * a8);
                const float sspe = row8_sum(dot4(kr));
                float rp[2];
#pragma unroll
                for (int p = 0; p < 2; ++p) {
                    const f32x4 xn = ld4bf(kvr + 128 * (4 * p + hh) + 4 * a);
                    const float ssn = row16_sum(dot4(xn));
                    const float r = rsqrtf((ssn + sspe) * (1.f / 96.f) + EPS); rp[p] = r;
                    *(GASP v2u*)(KM + (size_t)lr * 768 + 96 * (4 * p + hh) + 4 * a) = pk4(xn * g0k * r);
                    *(LAS v2u*)(stage + tk * 516 + 64 * (4 * p + hh) + 4 * a) = *(const GASP v2u*)(kvr + 128 * (4 * p + hh) + 64 + 4 * a);
                }
                const float r0 = __shfl(rp[0], 16 * (h8 & 3)), r1 = __shfl(rp[1], 16 * (h8 & 3));
                const float rr = (h8 < 4) ? r0 : r1;
                const f32x4 o = rope4(kr * g1k * rr, cA, cB, hi);
                *(GASP v2u*)(KM + (size_t)lr * 768 + 96 * h8 + 64 + 4 * a8) = pk4(o);
            }
        }
        __syncthreads();
#pragma unroll 2
        for (int jj = 0; jj < 8; ++jj) {
            const int it = F.tid + 512 * jj, hd = it >> 3, cc = it & 7;
            unsigned e[8];
#pragma unroll
            for (int j = 0; j < 8; ++j) e[j] = stage[(8 * cc + j) * 516 + hd];
            v4u o; o.x = e[0] | (e[1] << 16); o.y = e[2] | (e[3] << 16); o.z = e[4] | (e[5] << 16); o.w = e[6] | (e[7] << 16);
            *(GASP v4u*)(VTM + ((size_t)(bl * 512 + hd)) * 2048 + s0 + 8 * cc) = o;
        }
        __syncthreads();
    }
}

typedef __bf16 bf16x2_t __attribute__((ext_vector_type(2)));
__device__ __forceinline__ unsigned cvtpk(float lo, float hi) { const f32x2 v = {lo, hi}; const bf16x2_t b = __builtin_convertvector(v, bf16x2_t); return __builtin_bit_cast(unsigned, b); }
#define ATT_BAR() asm volatile("s_waitcnt lgkmcnt(0)\n\ts_barrier" ::: "memory")
template <int DQ>
__device__ __forceinline__ void attn_unit(LAS unsigned char* lds, const bf16* Qp, int ldq, const bf16* Kp, int ldk, const bf16* Vtp, bf16* Op, int tid, int lane, int wave) {
    constexpr int KP = DQ * 2 + 16, VP = 144, KBUF = 64 * KP, VBUF = 64 * VP, ND = DQ / 16, KCH = DQ / 8, NKC = 64 * KCH, NT = SEQ / 64;
    constexpr bool K2 = NKC > 512;
    constexpr float THR = 8.0f;
    const int q = lane & 31, hi = lane >> 5;
    bf16x8 qf[ND];
#pragma unroll
    for (int d0 = 0; d0 < ND; ++d0) qf[d0] = *(const GASP bf16x8*)(Qp + (size_t)(wave * 32 + q) * ldq + d0 * 16 + hi * 8);
    const int kr0 = tid / KCH, kc0 = tid % KCH, kr1 = (tid + 512) / KCH, kc1 = (tid + 512) % KCH;
    const bool k1v = K2 && (tid + 512 < NKC);
    const unsigned kg0 = (unsigned)(kr0 * ldk + kc0 * 8) * 2u;
    const unsigned kg1 = (unsigned)((k1v ? kr1 : 0) * ldk + (k1v ? kc1 : 0) * 8) * 2u;
    const int vd = tid >> 3, vc = tid & 7;
    const unsigned vg = (unsigned)(vd * 2048 + vc * 8) * 2u;
    const int ks0 = kr0 * KP + kc0 * 16, ks1 = kr1 * KP + kc1 * 16, vs = 2 * KBUF + vd * VP + vc * 16;
    const int pq = (q & 0x13) | ((q & 4) << 1) | ((q & 8) >> 1);
    const int ka = pq * KP + hi * 16, va = 2 * KBUF + q * VP + hi * 16;
#define LOADK(R, tile) do { const char* kt_ = (const char*)(Kp + (size_t)(tile) * 64 * ldk); R##_k0 = *(const GASP v4u*)(kt_ + kg0); if (K2) { if (k1v) R##_k1 = *(const GASP v4u*)(kt_ + kg1); } } while (0)
#define LOADV(R, tile) do { R##_v = *(const GASP v4u*)((const char*)(Vtp + (tile) * 64) + vg); } while (0)
#define STOREK(R, buf) do { *(LAS v4u*)(lds + (buf) * KBUF + ks0) = R##_k0; if (K2) { if (k1v) *(LAS v4u*)(lds + (buf) * KBUF + ks1) = R##_k1; } } while (0)
#define STOREV(R, buf) do { *(LAS v4u*)(lds + (buf) * VBUF + vs) = R##_v; } while (0)
#define QKT(S0, S1, buf, C0, C1) do { const LAS unsigned char* Kb_ = lds + (buf) * KBUF + ka; \
        _Pragma("unroll") for (int d0 = 0; d0 < ND; ++d0) { \
            const bf16x8 a0_ = *(const LAS bf16x8*)(Kb_ + d0 * 32), a1_ = *(const LAS bf16x8*)(Kb_ + 32 * KP + d0 * 32); \
            S0 = __builtin_amdgcn_mfma_f32_32x32x16_bf16(a0_, qf[d0], d0 == 0 ? C0 : S0, 0, 0, 0); \
            S1 = __builtin_amdgcn_mfma_f32_32x32x16_bf16(a1_, qf[d0], d0 == 0 ? C1 : S1, 0, 0, 0); } } while (0)
#define PVT(buf) do { const LAS unsigned char* Vb_ = lds + (buf) * VBUF + va; \
        _Pragma("unroll") for (int jj = 0; jj < 4; ++jj) { \
            const bf16x8 v0_ = *(const LAS bf16x8*)(Vb_ + jj * 32), v1_ = *(const LAS bf16x8*)(Vb_ + 32 * VP + jj * 32); \
            const bf16x8 pf_ = __builtin_bit_cast(bf16x8, pw[jj]); \
            o0 = __builtin_amdgcn_mfma_f32_32x32x16_bf16(v0_, pf_, o0, 0, 0, 0); \
            o1 = __builtin_amdgcn_mfma_f32_32x32x16_bf16(v1_, pf_, o1, 0, 0, 0); } } while (0)
    v4u a_k0, a_k1 = (v4u){0u, 0u, 0u, 0u}, a_v, b_k0, b_k1 = (v4u){0u, 0u, 0u, 0u}, b_v;
    LOADK(a, 0); LOADK(b, 1); LOADV(a, 0);
    STOREK(a, 0); STOREK(b, 1); STOREV(a, 1);
    LOADK(a, 2); LOADK(b, 3); LOADV(b, 1);
    ATT_BAR();
    f32x16 zero16, sc0, sc1, sn0, sn1, o0, o1, negm;
#pragma unroll
    for (int r = 0; r < 16; ++r) { zero16[r] = 0.f; o0[r] = 0.f; o1[r] = 0.f; }
    QKT(sc0, sc1, 0, zero16, zero16);
    float l_run = 0.f;
    {
        float mx = fmaxf(sc0[0], sc1[0]);
#pragma unroll
        for (int r = 1; r < 16; ++r) mx = fmaxf(mx, fmaxf(sc0[r], sc1[r]));
        mx = fmaxf(mx, __shfl_xor(mx, 32));
#pragma unroll
        for (int r = 0; r < 16; ++r) { sc0[r] -= mx; sc1[r] -= mx; negm[r] = -mx; }
    }
    v4u pw[4];
#pragma unroll
    for (int jj = 0; jj < 4; ++jj) pw[jj] = (v4u){0u, 0u, 0u, 0u};
#define FRAG_ADDR(i, BQ, BP) (((i) < 2 * ND) ? (lds + (BQ) * KBUF + ka + ((i) & 1) * 32 * KP + ((i) >> 1) * 32) \
                                             : (lds + (BP) * VBUF + va + (((i) - 2 * ND) & 1) * 32 * VP + (((i) - 2 * ND) >> 1) * 32))
#define SLICE(k, SC0, SC1, PW) do { \
        float e0_, e1_; \
        if ((k) < 8) { e0_ = __builtin_amdgcn_exp2f(SC0[2 * (k)]); e1_ = __builtin_amdgcn_exp2f(SC0[2 * (k) + 1]); } \
        else { e0_ = __builtin_amdgcn_exp2f(SC1[2 * (k) - 16]); e1_ = __builtin_amdgcn_exp2f(SC1[2 * (k) - 15]); } \
        lsA_ += e0_; lsB_ += e1_; \
        unsigned w_ = cvtpk(e0_, e1_); asm volatile("" : "+v"(w_), "+v"(lsA_), "+v"(lsB_)); PW[(k) >> 2][(k) & 3] = w_; \
    } while (0)
#define STAGE(t, R, BQ, BP, BS, PR, PW, SC0, SC1, SN0, SN1) do { \
        constexpr int NQ_ = 2 * ND, NM_ = NQ_ + 8; \
        constexpr int FD_ = 3, FR_ = FD_ + 1, SL0_ = 3;     \
        bf16x8 fr_[FR_]; \
        _Pragma("unroll") for (int i = 0; i < FD_; ++i) fr_[i] = *(const LAS bf16x8*)FRAG_ADDR(i, BQ, BP); \
        float lsA_ = 0.f, lsB_ = 0.f, mx_ = -INFINITY; \
        _Pragma("unroll") for (int k = 0; k < SL0_; ++k) { SLICE(k, SC0, SC1, PW); } \
        __builtin_amdgcn_sched_barrier(0); \
        _Pragma("unroll") for (int i = 0; i < NM_; ++i) { \
            if (i + FD_ < NM_) fr_[(i + FD_) % FR_] = *(const LAS bf16x8*)FRAG_ADDR(i + FD_, BQ, BP); \
            if (i < NQ_) { \
                const int d0_ = i >> 1; \
                if ((i & 1) == 0) SN0 = __builtin_amdgcn_mfma_f32_32x32x16_bf16(fr_[i % FR_], qf[d0_], d0_ == 0 ? negm : SN0, 0, 0, 0); \
                else              SN1 = __builtin_amdgcn_mfma_f32_32x32x16_bf16(fr_[i % FR_], qf[d0_], d0_ == 0 ? negm : SN1, 0, 0, 0); \
            } else { \
                const int j_ = i - NQ_; const bf16x8 pf_ = __builtin_bit_cast(bf16x8, PR[j_ >> 1]); \
                if ((j_ & 1) == 0) o0 = __builtin_amdgcn_mfma_f32_32x32x16_bf16(fr_[i % FR_], pf_, o0, 0, 0, 0); \
                else               o1 = __builtin_amdgcn_mfma_f32_32x32x16_bf16(fr_[i % FR_], pf_, o1, 0, 0, 0); \
            } \
            if (i + SL0_ < 16) { SLICE(i + SL0_, SC0, SC1, PW); }                  \
            if (i >= NM_ - 6) { \
                _Pragma("unroll") for (int r = 3 * (i - (NM_ - 6)); r < 3 * (i - (NM_ - 6)) + 3; ++r) if (r < 16) mx_ = fmaxf(fmaxf(mx_, SN0[r]), SN1[r]); \
                asm volatile("" : "+v"(mx_)); \
            } \
            if (i == 13) { STOREK(R, BS); }                    \
            if (i == 14) { STOREV(R, BS); } \
            if (i == 15) { const int tk_ = ((t) + 4 < NT) ? (t) + 4 : NT - 1, tv_ = ((t) + 2 < NT) ? (t) + 2 : NT - 1; LOADK(R, tk_); LOADV(R, tv_); } \
            __builtin_amdgcn_sched_barrier(0); \
        } \
        l_run = l_run * al_pend + (lsA_ + lsB_); \
        ATT_BAR(); \
        if (pend) { _Pragma("unroll") for (int r = 0; r < 16; ++r) { o0[r] *= al_pend; o1[r] *= al_pend; } } \
        pend = false; al_pend = 1.0f; \
        if (__any(mx_ > THR)) { \
            const float rm_ = fmaxf(mx_, __shfl_xor(mx_, 32)); \
            const float dl_ = fmaxf(rm_, 0.f); \
            al_pend = __builtin_amdgcn_exp2f(-dl_); pend = true; \
            _Pragma("unroll") for (int r = 0; r < 16; ++r) { SN0[r] -= dl_; SN1[r] -= dl_; negm[r] -= dl_; } \
        } \
    } while (0)
    float al_pend = 1.0f; bool pend = false;
    v4u pw2[4];
    for (int t = 0; t < NT; t += 2) {
        STAGE(t, a, 1, 1, 0, pw, pw2, sc0, sc1, sn0, sn1);
        STAGE(t + 1, b, 0, 0, 1, pw2, pw, sn0, sn1, sc0, sc1);
    }
#undef FRAG_ADDR
#undef SLICE
    PVT(1);
    l_run += __shfl_xor(l_run, 32);
    const float inv = __builtin_amdgcn_rcpf(l_run);
    bf16* orow = Op + (size_t)(wave * 32 + q) * 512 + 4 * hi;
#pragma unroll
    for (int a = 0; a < 4; ++a) {
        v2u w0, w1;
        w0.x = cvtpk(o0[4 * a] * inv, o0[4 * a + 1] * inv); w0.y = cvtpk(o0[4 * a + 2] * inv, o0[4 * a + 3] * inv);
        w1.x = cvtpk(o1[4 * a] * inv, o1[4 * a + 1] * inv); w1.y = cvtpk(o1[4 * a + 2] * inv, o1[4 * a + 3] * inv);
        *(GASP v2u*)(orow + 8 * a) = w0; *(GASP v2u*)(orow + 32 + 8 * a) = w1;
    }
    ATT_BAR();
#undef LOADK
#undef LOADV
#undef STOREK
#undef STOREV
#undef QKT
#undef PVT
#undef STAGE
}

__device__ __forceinline__ void attn_phase(Frame& F, unsigned char* ws) {
    const bf16* QM = (const bf16*)(ws + WS_QM); const bf16* KM = (const bf16*)(ws + WS_KM); const bf16* VTM = (const bf16*)(ws + WS_VTM); bf16* OM = (bf16*)(ws + WS_OM);
    const bf16* QG = (const bf16*)(ws + WS_QG); const bf16* KG = (const bf16*)(ws + WS_KG); const bf16* VTG = (const bf16*)(ws + WS_VTG); bf16* OG = (bf16*)(ws + WS_OG);
    constexpr int NU = 16 * 8 * 8;
    for (int lu = F.xr; lu < 256; lu += F.nx) {
        const int U = (lu < 128) ? (2 * F.xid) * 64 + lu : NU + (2 * F.xid) * 64 + (lu - 128);
        int tid_ = F.tid; asm volatile("" : "+v"(tid_));
        const int lane_ = tid_ & 63, wave_ = __builtin_amdgcn_readfirstlane(tid_ >> 6);
        if (U < NU) {
            const int qb = U & 7, h = (U >> 3) & 7, bl = U >> 6;
            const size_t r0 = (size_t)bl * 2048;
            attn_unit<96>(F.lds, QM + (r0 + qb * 256) * 768 + h * 96, 768, KM + r0 * 768 + h * 96, 768, VTM + (size_t)((bl * 8 + h) * 64) * 2048, OM + (r0 + qb * 256) * 512 + h * 64, tid_, lane_, wave_);
        } else {
            const int u = U - NU, qb = u & 7, hq = (u >> 3) & 7, bl = u >> 6, kvh = hq >> 2;
            const size_t r0 = (size_t)bl * 2048;
            attn_unit<64>(F.lds, QG + (r0 + qb * 256) * 512 + hq * 64, 512, KG + r0 * 128 + kvh * 64, 128, VTG + (size_t)((bl * 2 + kvh) * 64) * 2048, OG + (r0 + qb * 256) * 512 + hq * 64, tid_, lane_, wave_);
        }
    }
}

typedef __attribute__((address_space(1))) unsigned gu32;
#define XB_TMO      128
#define XB_XCNT(j)  (256  + 64 * (j))
#define XB_XSUB(j)  (1280 + 64 * (j))
#define XB_XGEN(j)  (2304 + 64 * (j))
#define XB_TOP      3328
#define XB_TOPGEN   3392
#define XCD_BAR_WORDS 3456
#define XB_SPIN_CAP (1u << 18)

__device__ __forceinline__ unsigned xb_ld(unsigned* p)              { return __hip_atomic_load(p, __ATOMIC_RELAXED, __HIP_MEMORY_SCOPE_AGENT); }
__device__ __forceinline__ unsigned xb_add(unsigned* p, unsigned v) { return __hip_atomic_fetch_add(p, v, __ATOMIC_RELAXED, __HIP_MEMORY_SCOPE_AGENT); }
__device__ __forceinline__ unsigned xb_xcc_id() { return (unsigned)__builtin_amdgcn_s_getreg((3 << 11) | 20) & 0xFu; }
#define XB_SPIN(cond, bar) do { unsigned _sp = 0; while (cond) { __builtin_amdgcn_s_sleep(1); \
    if ((++_sp & 255u) == 0u) { if (xb_ld(&(bar)[XB_TMO])) break; if (_sp > XB_SPIN_CAP) { atomicAdd(&(bar)[XB_TMO], 1u); break; } } } } while (0)

struct XcdBarrier {
    unsigned* bar; unsigned x;
    volatile LAS unsigned* st;
};

__device__ __forceinline__ XcdBarrier xcd_barrier_post(unsigned* bar, volatile LAS unsigned* st) {
    XcdBarrier b; b.bar = bar; b.x = xb_xcc_id(); b.st = st;
    if (threadIdx.x == 0) (void)xb_add(&bar[XB_XCNT(b.x)], 1u);
    return b;
}
__device__ __forceinline__ void xcd_barrier_complete(unsigned* bar, unsigned x, unsigned& nloc, unsigned& nx) {
    const unsigned G = gridDim.x * gridDim.y * gridDim.z;
    unsigned sum, cnt, mine, sp = 0u;
    for (;;) {
        sum = 0u; cnt = 0u; mine = 0u;
#pragma unroll
        for (unsigned j = 0; j < 16; ++j) { const unsigned c = xb_ld(&bar[XB_XCNT(j)]); sum += c; cnt += (c > 0u) ? 1u : 0u; mine = (j == x) ? c : mine; }
        if (sum == G) break;
        __builtin_amdgcn_s_sleep(1);
        if ((++sp & 255u) == 0u) { if (xb_ld(&bar[XB_TMO])) break; if (sp > XB_SPIN_CAP) { atomicAdd(&bar[XB_TMO], 1u); break; } }
    }
    nloc = mine > 0u ? mine : 1u; nx = cnt > 0u ? cnt : 1u;
}

__device__ __forceinline__ void xcd_barrier(const XcdBarrier& b) {
    asm volatile("s_waitcnt vmcnt(0)" ::: "memory");
    __syncthreads();
    if (threadIdx.x == 0) {
        unsigned* bar = b.bar;
        __builtin_amdgcn_s_waitcnt(0);
        unsigned nloc = b.st[0], nx = b.st[1];
        if (nloc == 0u) { xcd_barrier_complete(bar, b.x, nloc, nx); b.st[0] = nloc; b.st[1] = nx; }
        const unsigned old = xb_add(&bar[XB_XSUB(b.x)], 1u);
        const unsigned gen = old / nloc;
        if (old + 1u == (gen + 1u) * nloc) {
            __builtin_amdgcn_fence(__ATOMIC_RELEASE, "agent");
            asm volatile("s_waitcnt vmcnt(0)" ::: "memory");
            const unsigned og = xb_add(&bar[XB_TOP], 1u);
            const unsigned tg = og / nx;
            if (og + 1u == (tg + 1u) * nx) xb_add(&bar[XB_TOPGEN], 1u);
            else XB_SPIN(xb_ld(&bar[XB_TOPGEN]) == tg, bar);
            __builtin_amdgcn_fence(__ATOMIC_ACQUIRE, "agent");
            xb_add(&bar[XB_XGEN(b.x)], 1u);
            asm volatile("s_waitcnt vmcnt(0)" ::: "memory");
        } else {
            XB_SPIN(xb_ld(&bar[XB_XGEN(b.x)]) == gen, bar);
            __builtin_amdgcn_fence(__ATOMIC_ACQUIRE, "agent");
            asm volatile("s_waitcnt vmcnt(0)" ::: "memory");
        }
    }
    __syncthreads();
}

#define LB_SUB(j) (XCD_BAR_WORDS + 64 * (j))
#define LB_GEN(j) (XCD_BAR_WORDS + 512 + 64 * (j))
__device__ __forceinline__ void xcd_local_barrier(unsigned* bar, unsigned x, unsigned nx) {
    asm volatile("s_waitcnt vmcnt(0)" ::: "memory");
    __syncthreads();
    if (threadIdx.x == 0) {
        const unsigned old = xb_add(&bar[LB_SUB(x)], 1u);
        const unsigned gen = old / nx;
        if (old + 1u == (gen + 1u) * nx) xb_add(&bar[LB_GEN(x)], 1u);
        else XB_SPIN(xb_ld(&bar[LB_GEN(x)]) == gen, bar);
        __builtin_amdgcn_fence(__ATOMIC_ACQUIRE, "agent");
        asm volatile("s_waitcnt vmcnt(0)" ::: "memory");
    }
    __syncthreads();
}

template <class Epi>
__device__ __forceinline__ void run_gemm(Frame& F, const bf16* A, int lda, const bf16* Bt, int pm0, int LP, int N, int K, const Epi& E, int rev = 0) {
    pg8::Gemm g{A, Bt, TOK, N, K, lda}; pg8::XcdOrder S; S.init(pm0, LP, N, F.xr, F.nx, rev);
    pg8::gemm_phase<Epi, pg8::XcdOrder, true, true>(F.lds, g, S, E, F.tid);
}

constexpr int STEPS_PER_LAYER = 21, NSTEPS = 1 + DEPTH * STEPS_PER_LAYER;

__global__ void __launch_bounds__(NTHR, 2) fwd_megakernel(Args args) {
    extern __shared__ __attribute__((aligned(16))) unsigned char lds_raw[];
    cg::grid_group grid = cg::this_grid();
    const Args* ap = (const Args*)__builtin_amdgcn_kernarg_segment_ptr();
    volatile LAS unsigned* bst = (volatile LAS unsigned*)((LAS unsigned char*)lds_raw + 131072 + 64);
    if (threadIdx.x < 8) bst[threadIdx.x] = 0u;
    __syncthreads();
    for (int step = 0; step < NSTEPS; ++step) {
        asm volatile("" : "+s"(ap));
        const Args& args_ = *ap;
        Frame F;
        F.lds = (LAS unsigned char*)lds_raw;
        { int t_ = threadIdx.x; asm volatile("" : "+v"(t_)); F.tid = t_; }
        F.lane = F.tid & 63; F.wave = __builtin_amdgcn_readfirstlane(F.tid >> 6);
        { int b_ = blockIdx.x, g_ = gridDim.x; asm volatile("" : "+s"(b_), "+s"(g_)); F.bx = b_; F.G = g_; }
        F.vcu = (F.G % 8 == 0) ? (F.bx % 8) * (F.G / 8) + F.bx / 8 : F.bx;
        const bool local_ok = __builtin_amdgcn_readfirstlane(bst[4]) != 0u;
        if (local_ok) { F.xid = __builtin_amdgcn_readfirstlane(bst[2]); F.xr = __builtin_amdgcn_readfirstlane(bst[3]); F.nx = __builtin_amdgcn_readfirstlane(bst[0]); }
        else { F.xid = F.bx % 8; F.xr = F.bx / 8; F.nx = (F.G - F.xid + 7) / 8; }
        unsigned char* ws = uni(args_.ws);
        float* out = uni(args_.out);
        bool chip_wide = false;
        if (step == 0) {
            if (F.bx == 0) for (int i = F.tid; i < XCD_BAR_WORDS + 1024; i += NTHR) ((unsigned*)(ws + WS_BAR))[i] = 0u;
            p0_prologue(F, args_, ws);
        } else {
            const int sidx = step - 1, l = sidx / STEPS_PER_LAYER, ps = sidx % STEPS_PER_LAYER;
            int kind, hf = 0;
            if (ps < 4) kind = ps; else if (ps < 18) { hf = (ps - 4) / 7; kind = 4 + (ps - 4) % 7; } else kind = 11 + (ps - 18);
            chip_wide = false;
            const float* modl = (const float*)(ws + WS_MOD) + (size_t)l * 32 * NMODC;
            const bf16* W = (const bf16*)(ws + WS_WT) + (size_t)l * LW;
#define U_ ((bf16*)(ws + WS_U))
#define HID_ ((bf16*)(ws + WS_HID))
            const size_t hlo = (size_t)4096 * F.xid, fro = hlo + (size_t)4096 * hf;
            unsigned char* arena = ws + WS_X + (size_t)F.xid * ARENA;
            bf16* Gh = (bf16*)(arena + AR_G) - hlo * 2048; bf16* ZGh = (bf16*)(arena + AR_ZG) - hlo * 768; bf16* ZMh = (bf16*)(arena + AR_ZM) - hlo * 768;
            bf16* QRh = (bf16*)(arena + AR_QRAW) - hlo * 768; bf16* KVh = (bf16*)(arena + AR_KVRAW) - hlo * 1024;
            const int pmF = 32 * F.xid, pmH = 32 * F.xid + 16 * hf;
            if (kind == 0 || kind == 3 || kind == 11) {
                const bool fromx = (kind == 0 && l == 0);
                const void* hin = fromx ? (const void*)uni(args_.in[0]) : (const void*)(ws + WS_H);
                const float* gain = (kind == 0 ? uni(args_.in[4]) : kind == 3 ? uni(args_.in[7]) : uni(args_.in[20])) + l * DM;
                const int mi = (kind == 0) ? 0 : (kind == 3) ? 3 : 6;
                norm_phase(F, hin, fromx ? 0 : 1, gain, modl + mi * DM, modl + (mi + 1) * DM, U_);
            } else if (kind == 1 || kind == 12) {
                pg8::EpiB<0> E{HID_, FF, nullptr, nullptr, nullptr, nullptr, 0};
                run_gemm(F, U_, DM, W + (kind == 1 ? (size_t)0 : (size_t)14974976), pmF, 32, 2 * FF, DM, E);
            } else if (kind == 2 || kind == 10 || kind == 13) {
                if (kind == 10) {
                    bf16* hh = (bf16*)(ws + WS_H);
                    pg8::EpiRes E{hh, hh, modl + 5 * DM, 1.0f, 0, 1, 1};
                    run_gemm(F, (const bf16*)(ws + WS_MG) - fro * 1024, 1024, W + 13926400, pmH, 16, DM, DM, E);
                } else {
                    const bool fromx = (kind == 2 && l == 0), last = (kind == 13 && l == DEPTH - 1);
                    const void* hin = fromx ? (const void*)uni(args_.in[0]) : (const void*)(ws + WS_H);
                    void* hout = last ? (void*)out : (void*)(ws + WS_H);
                    pg8::EpiRes E{hin, hout, modl + (kind == 2 ? 2 : 8) * DM, 0.5f, 0, fromx ? 0 : 1, last ? 0 : 1};
                    run_gemm(F, HID_, FF, W + (kind == 2 ? (size_t)5767168 : (size_t)20742144), pmF, 32, DM, FF, E, 1);
                }
            } else if (kind == 4) {
                pg8::EpiB<1> E{Gh - fro * 2048, 2048, ZGh - fro * 768, ZMh - fro * 768, nullptr, nullptr, 0};
                run_gemm(F, U_, DM, W + 8650752, pmH, 16, 3584, DM, E);
            } else if (kind == 5) {
                pp1_phase(F, ws, ZGh, ZMh, uni(args_.in[15]) + l * 64, uni(args_.in[16]) + l * 64);
            } else if (kind == 6) {
                for (int w = 0; w < 2; ++w) {
                    pg8::EpiB<2> E{(w == 0 ? QRh - fro * 768 : KVh - fro * 1024), w == 0 ? 768 : 1024, nullptr, nullptr, nullptr, (const float*)(ws + (w == 0 ? WS_RSQ : WS_RSKV)) - fro, 0};
                    run_gemm(F, ZMh - fro * 768 + (w == 0 ? 0 : 384), 768, W + (w == 0 ? (size_t)12320768 : (size_t)12615680), pmH, 16, w == 0 ? 768 : 1024, w == 0 ? 384 : 256, E);
                }
            } else if (kind == 7) {
                pp2_phase(F, ws, QRh, KVh, ZMh, uni(args_.in[13]) + l * 96, uni(args_.in[14]) + l * 96);
            } else if (kind == 8) {
                attn_phase(F, ws);
            } else if (kind == 9) {
                for (int w = 0; w < 2; ++w) {
                    pg8::EpiB<3> E{(bf16*)(ws + WS_MG) - fro * 1024, 1024, nullptr, nullptr, Gh - fro * 2048, nullptr, w};
                    run_gemm(F, (const bf16*)(ws + (w == 0 ? WS_OM : WS_OG)) - fro * 512, 512, W + (w == 0 ? (size_t)12877824 : (size_t)13402112), pmH, 16, DM, 512, E);
                }
            }
        }
        unsigned* barw = (unsigned*)(ws + WS_BAR);
        if (step == 0) {
            grid.sync();
            if (threadIdx.x == 0) { const unsigned x = xb_xcc_id(); bst[2] = x; bst[3] = xb_add(&barw[XB_XCNT(x)], 1u); }
            __syncthreads();
            XcdBarrier bar; bar.bar = barw; bar.x = xb_xcc_id(); bar.st = bst;
            xcd_barrier(bar);
            if (threadIdx.x == 0) {
                bool ok = true;
                for (unsigned j = 0; j < 16; ++j) { const unsigned c = xb_ld(&barw[XB_XCNT(j)]); ok = ok && ((j < 8) ? (c > 0u) : (c == 0u)); }
                bst[4] = (ok && xb_ld(&barw[XB_TMO]) == 0u) ? 1u : 0u;
            }
            __syncthreads();
        } else if (step + 1 < NSTEPS) {
            if (local_ok && !chip_wide) xcd_local_barrier(barw, (unsigned)F.xid, (unsigned)F.nx);
            else { XcdBarrier bar; bar.bar = barw; bar.x = xb_xcc_id(); bar.st = bst; xcd_barrier(bar); }
        }
    }
}

extern "C" void kernel_launch(void* const* d_in, const int* in_sizes, int n_in, void* d_out, int out_size, void* d_ws, size_t ws_size, hipStream_t stream) {
    static int grid = 0;
    if (grid == 0) {
        if (n_in != 23 || out_size != TOK * DM || ws_size < WS_END) { fprintf(stderr, "kernel_launch: unexpected shapes (n_in %d, out %d, ws %zu < %zu)\n", n_in, out_size, ws_size, (size_t)WS_END); grid = -1; return; }
        int dev = 0, cus = 0, per_cu = 0;
        hipGetDevice(&dev);
        hipDeviceGetAttribute(&cus, hipDeviceAttributeMultiprocessorCount, dev);
        hipFuncSetAttribute((const void*)fwd_megakernel, hipFuncAttributeMaxDynamicSharedMemorySize, LDS_BYTES);
        hipOccupancyMaxActiveBlocksPerMultiprocessor(&per_cu, (const void*)fwd_megakernel, NTHR, LDS_BYTES);
        if (per_cu < 1) per_cu = 1;
        grid = cus * per_cu;
        (void)hipGetLastError();
    }
    if (grid < 0) return;
    Args a{};
    for (int i = 0; i < 23; ++i) a.in[i] = (const float*)d_in[i];
    a.out = (float*)d_out; a.ws = (unsigned char*)d_ws;
    void* kargs[] = {&a};
    hipError_t e = hipLaunchCooperativeKernel((const void*)fwd_megakernel, dim3(grid), dim3(NTHR), kargs, LDS_BYTES, stream);
    if (e != hipSuccess) fprintf(stderr, "cooperative launch failed: %s (grid %d)\n", hipGetErrorString(e), grid);
}
```

```cpp
#include <hip/hip_runtime.h>
#include <hip/hip_cooperative_groups.h>
#include <cstdio>
#include <cstdint>
namespace cg = cooperative_groups;

namespace pg8 {
#define PG8_LAS __attribute__((address_space(3)))
#define PG8_GAS __attribute__((address_space(1)))
typedef unsigned short bf16_t;
typedef short bf16x8 __attribute__((ext_vector_type(8)));
typedef float f32x4 __attribute__((ext_vector_type(4)));
typedef unsigned u32x4 __attribute__((ext_vector_type(4)));
constexpr int BM = 256, BK = 64, HALF = 128, HTB = HALF * BK * 2  , STAGE_BYTES = 8 * HTB, NXCD = 8, WGM = 8;

__host__ __device__ __forceinline__ int lds_byte(int r, int c) { const int st = (r >> 4) * 2 + (c >> 5), rr = r & 15, cc = c & 31, ob = rr * 64 + cc * 2; return st * 1024 + (ob ^ (((ob >> 9) & 1) << 5)); }
__host__ __device__ __forceinline__ void stage_rc(int b, int& R, int& C) { const int st = b / 1024, sb = b % 1024, swz = sb ^ (((sb >> 9) & 1) << 5); R = (st >> 1) * 16 + swz / 64; C = (st & 1) * 32 + (swz % 64) / 2; }
__host__ __device__ __forceinline__ int perm32(int rho) { const int n = rho >> 4, i = rho & 15; return 8 * (i >> 2) + 4 * n + (i & 3); }

struct Unit { int pm, pn; };
struct Gemm { const bf16_t* A; const bf16_t* Bt; int M, N, K, lda; };

struct StaticOrder {
    int nM, nN, nwg, G, c, rev;
    __host__ __device__ void init(int M, int N, int G_, int c_, int rev_ = 0) { nM = M / BM; nN = N / BM; nwg = nM * nN; G = G_; c = c_; rev = rev_; }
    __host__ __device__ bool next(int i, Unit& u) const {
        const long L = (long)i * G + c; if (L >= nwg) return false;
        int wgid = rev ? (nwg - 1 - (int)L) : (int)L; { const int q = nwg / NXCD, r = nwg % NXCD, xcd = wgid % NXCD, off = wgid / NXCD; wgid = (xcd < r ? xcd * (q + 1) : r * (q + 1) + (xcd - r) * q) + off; }
        const int nig = WGM * nN, gid = wgid / nig, fm = gid * WGM, gsz = (nM - fm) < WGM ? (nM - fm) : WGM;
        u.pm = fm + ((wgid % nig) % gsz); u.pn = (wgid % nig) / gsz; return true;
    }
    __device__ __forceinline__ void a_ready(const Unit&) const {}
    __device__ __forceinline__ void done(const Unit&) const {}
};

struct XcdOrder {
    int nN, q, r, nx, rev, pm0;
    __device__ void init(int pm0_, int LP, int N, int r_, int nx_, int rev_) { nN = N / BM; q = LP * nN; pm0 = pm0_; r = r_; nx = nx_; rev = rev_; }
    __device__ bool next(int i, Unit& u) const {
        int off = i * nx + r; if (off >= q) return false;
        if (rev) off = q - 1 - off;
        const int nig = WGM * nN, gid = off / nig, rem = off % nig;
        u.pn = rem / WGM; u.pm = pm0 + gid * WGM + rem % WGM; return true;
    }
    __device__ __forceinline__ void a_ready(const Unit&) const {}
    __device__ __forceinline__ void done(const Unit&) const {}
};

typedef float f32x2_ __attribute__((ext_vector_type(2))); typedef __bf16 bf16x2_ __attribute__((ext_vector_type(2)));
__device__ __forceinline__ unsigned cvt_pk_bf16(float lo, float hi) { const f32x2_ v = {lo, hi}; const bf16x2_ b = __builtin_convertvector(v, bf16x2_); return __builtin_bit_cast(unsigned, b); }
__device__ __forceinline__ float bf_lo(unsigned w) { return __uint_as_float(w << 16); }
__device__ __forceinline__ float bf_hi(unsigned w) { return __uint_as_float(w & 0xffff0000u); }
__device__ __forceinline__ float sigmoidf_(float x) { return __builtin_amdgcn_rcpf(1.0f + __builtin_amdgcn_exp2f(x * -1.4426950408889634f)); }

template <int MODE> struct EpiB {
    static constexpr bool PERM = true, AFTER_DRAIN = false;
    bf16_t* O; int ldc; bf16_t* O2; bf16_t* O3; const bf16_t* Gt; const float* rs; int add;
    __device__ __forceinline__ void operator()(const f32x4 (&acc)[2][2][4][2], const Unit& u, int wr, int wc, int fr, int fq) const {
        const int row0 = u.pm * BM + wr * 64 + fr;
        if constexpr (MODE == 0) {
            const int col0 = u.pn * HALF + wc * 32 + 8 * fq;
#pragma unroll
            for (int ai = 0; ai < 2; ++ai)
#pragma unroll
                for (int m = 0; m < 4; ++m) {
                    bf16_t* rowp = O + (size_t)(row0 + ai * HALF + m * 16) * ldc + col0;
                    const f32x4 a0 = acc[ai][0][m][0], a1 = acc[ai][0][m][1], b0 = acc[ai][1][m][0], b1 = acc[ai][1][m][1];
                    const float av[8] = {a0[0], a0[1], a0[2], a0[3], a1[0], a1[1], a1[2], a1[3]}, bv[8] = {b0[0], b0[1], b0[2], b0[3], b1[0], b1[1], b1[2], b1[3]};
                    float e[8], o[8];
#pragma unroll
                    for (int j = 0; j < 8; ++j) e[j] = __builtin_amdgcn_exp2f(-av[j]);
#pragma unroll
                    for (int j = 0; j < 8; ++j) e[j] = 1.0f + e[j];
#pragma unroll
                    for (int j = 0; j < 8; ++j) e[j] = __builtin_amdgcn_rcpf(e[j]);
#pragma unroll
                    for (int j = 0; j < 8; ++j) o[j] = (av[j] * bv[j]) * e[j];
                    u32x4 w; w.x = cvt_pk_bf16(o[0], o[1]); w.y = cvt_pk_bf16(o[2], o[3]); w.z = cvt_pk_bf16(o[4], o[5]); w.w = cvt_pk_bf16(o[6], o[7]);
                    *(PG8_GAS u32x4*)rowp = w;
                }
        } else {
            bf16_t* base = O; int ld = ldc; int colt = u.pn * BM;
            if constexpr (MODE == 1) { if (u.pn >= 11) { base = O3; ld = 768; colt = (u.pn - 11) * BM; } else if (u.pn >= 8) { base = O2; ld = 768; colt = (u.pn - 8) * BM; } }
            const int col0 = colt + wc * 32 + 8 * fq;
#pragma unroll
            for (int ai = 0; ai < 2; ++ai) {
                float rsc[4]; u32x4 gg[4][2], qq[4][2];
#pragma unroll
                for (int m = 0; m < 4; ++m) {
                    const int row = row0 + ai * HALF + m * 16;
                    rsc[m] = 1.f; if constexpr (MODE == 2) rsc[m] = *(const PG8_GAS float*)(rs + row);
#pragma unroll
                    for (int bj = 0; bj < 2; ++bj) {
                        if constexpr (MODE == 3) {
                            gg[m][bj] = *(const PG8_GAS u32x4*)(Gt + (size_t)row * 2048 + (add ? 1024 : 0) + col0 + bj * HALF);
                            if (add) qq[m][bj] = *(const PG8_GAS u32x4*)(base + (size_t)row * ld + col0 + bj * HALF);
                        }
                    }
                }
                asm volatile("" ::: "memory");
#pragma unroll
                for (int m = 0; m < 4; ++m) {
                    const int row = row0 + ai * HALF + m * 16;
#pragma unroll
                    for (int bj = 0; bj < 2; ++bj) {
                        bf16_t* p = base + (size_t)row * ld + col0 + bj * HALF;
                        f32x4 v0 = acc[ai][bj][m][0], v1 = acc[ai][bj][m][1];
                        if constexpr (MODE == 2) { v0 = v0 * rsc[m]; v1 = v1 * rsc[m]; }
                        if constexpr (MODE == 3) {
                            const u32x4 g = gg[m][bj];
                            v0[0] *= sigmoidf_(bf_lo(g.x)); v0[1] *= sigmoidf_(bf_hi(g.x)); v0[2] *= sigmoidf_(bf_lo(g.y)); v0[3] *= sigmoidf_(bf_hi(g.y));
                            v1[0] *= sigmoidf_(bf_lo(g.z)); v1[1] *= sigmoidf_(bf_hi(g.z)); v1[2] *= sigmoidf_(bf_lo(g.w)); v1[3] *= sigmoidf_(bf_hi(g.w));
                            if (add) {
                                const u32x4 q = qq[m][bj];
                                v0[0] += bf_lo(q.x); v0[1] += bf_hi(q.x); v0[2] += bf_lo(q.y); v0[3] += bf_hi(q.y);
                                v1[0] += bf_lo(q.z); v1[1] += bf_hi(q.z); v1[2] += bf_lo(q.w); v1[3] += bf_hi(q.w);
                            }
                        }
                        u32x4 w; w.x = cvt_pk_bf16(v0[0], v0[1]); w.y = cvt_pk_bf16(v0[2], v0[3]); w.z = cvt_pk_bf16(v1[0], v1[1]); w.w = cvt_pk_bf16(v1[2], v1[3]);
                        *(PG8_GAS u32x4*)p = w;
                    }
                }
                asm volatile("" ::: "memory");
            }
        }
    }
};
struct EpiRes {
    static constexpr bool PERM = false, AFTER_DRAIN = false;
    const void* base; void* out; const float* gate; float coef; int row_off; int in_bf, out_bf;
    __device__ __forceinline__ void operator()(const f32x4 (&acc)[2][2][4][2], const Unit& u, int wr, int wc, int fr, int fq) const {
        typedef unsigned u32x2 __attribute__((ext_vector_type(2)));
        const int b = (u.pm * BM + row_off) >> 11;
        const int col0 = u.pn * BM + wc * 32 + 4 * fq;
        f32x4 gv[2][2];
#pragma unroll
        for (int bj = 0; bj < 2; ++bj)
#pragma unroll
            for (int n = 0; n < 2; ++n) gv[bj][n] = *(const PG8_GAS f32x4*)(gate + (size_t)b * 9216 + col0 + bj * HALF + n * 16) * coef;
#pragma unroll
        for (int ai = 0; ai < 2; ++ai)
#pragma unroll
            for (int mh = 0; mh < 2; ++mh) {
                u32x4 raw[2][2][2];
#pragma unroll
                for (int mm = 0; mm < 2; ++mm) {
                    const size_t off = (size_t)(u.pm * BM + ai * HALF + wr * 64 + (2 * mh + mm) * 16 + fr) * 1024 + col0;
#pragma unroll
                    for (int bj = 0; bj < 2; ++bj)
#pragma unroll
                        for (int n = 0; n < 2; ++n) {
                            const size_t o = off + bj * HALF + n * 16;
                            if (in_bf) { const u32x2 w = *(const PG8_GAS u32x2*)((const bf16_t*)base + o); raw[mm][bj][n].x = w.x; raw[mm][bj][n].y = w.y; }
                            else raw[mm][bj][n] = *(const PG8_GAS u32x4*)((const float*)base + o);
                        }
                }
                asm volatile("" ::: "memory");
#pragma unroll
                for (int mm = 0; mm < 2; ++mm) {
                    const int m = 2 * mh + mm;
                    const size_t off = (size_t)(u.pm * BM + ai * HALF + wr * 64 + m * 16 + fr) * 1024 + col0;
#pragma unroll
                    for (int bj = 0; bj < 2; ++bj)
#pragma unroll
                        for (int n = 0; n < 2; ++n) {
                            const size_t o = off + bj * HALF + n * 16;
                            const u32x4 w4 = raw[mm][bj][n];
                            f32x4 bs;
                            if (in_bf) bs = (f32x4){bf_lo(w4.x), bf_hi(w4.x), bf_lo(w4.y), bf_hi(w4.y)};
                            else bs = (f32x4){__uint_as_float(w4.x), __uint_as_float(w4.y), __uint_as_float(w4.z), __uint_as_float(w4.w)};
                            const f32x4 r = bs + gv[bj][n] * acc[ai][bj][m][n];
                            if (out_bf) { u32x2 w; w.x = cvt_pk_bf16(r[0], r[1]); w.y = cvt_pk_bf16(r[2], r[3]); *(PG8_GAS u32x2*)((bf16_t*)out + o) = w; }
                            else *(PG8_GAS f32x4*)((float*)out + o) = r;
                        }
                }
                asm volatile("" ::: "memory");
            }
    }
};

template <class Epi, class Sched, bool ALIGN_EPI = false, bool SP2 = false>
__device__ __forceinline__ void gemm_phase(PG8_LAS unsigned char* lds, const Gemm g, const Sched& S, const Epi& E, const int tid) {
    const int wid = __builtin_amdgcn_readfirstlane(tid >> 6), lane = tid & 63, wr = wid >> 2, wc = wid & 3, fr = lane & 15, fq = lane >> 4;
    const int K = g.K, lda = g.lda, nt = K / BK;
    unsigned voffA[2], voffB[2];
#pragma unroll
    for (int i = 0; i < 2; ++i) { int R, C; stage_rc(tid * 16 + i * 8192, R, C); const int Rb = Epi::PERM ? ((R & ~31) + perm32(R & 31)) : R;
        voffA[i] = (unsigned)(R * lda + C) * 2u; voffB[i] = (unsigned)(Rb * K + C) * 2u; }
    const size_t kstep = (size_t)(BK * 2);
    const size_t hstepA = (size_t)HALF * lda * 2, hstepB = (size_t)HALF * K * 2;
    const size_t tstepA = 2 * hstepA, tstepB = 2 * hstepB;
    const unsigned ldsw = (unsigned)wid * 1024u;
    const int aoff = lds_byte(wr * 64 + fr, fq * 8), boff = lds_byte(wc * 32 + fr, fq * 8);
#define PG8_SA(b, h) (((b) * 2 + (h)) * HTB)
#define PG8_SB(b, h) ((4 + (b) * 2 + (h)) * HTB)
#define PG8_STAGE(bufoff, gbase, voff) do { _Pragma("unroll") for (int _i = 0; _i < 2; ++_i) \
        __builtin_amdgcn_global_load_lds((const unsigned*)((const char*)(gbase) + (voff)[_i]), (PG8_LAS unsigned*)(lds + (bufoff) + ldsw + _i * 8192), 16, 0, 0); } while (0)
#define PG8_LDA(dst, b, h) do { _Pragma("unroll") for (int m = 0; m < 4; ++m) _Pragma("unroll") for (int k = 0; k < 2; ++k) dst[m][k] = *(const PG8_LAS bf16x8*)(lds + PG8_SA(b, h) + aoff + m * 2048 + k * 1024); } while (0)
#define PG8_LDB(dst, b, h) do { _Pragma("unroll") for (int n = 0; n < 2; ++n) _Pragma("unroll") for (int k = 0; k < 2; ++k) dst[n][k] = *(const PG8_LAS bf16x8*)(lds + PG8_SB(b, h) + boff + n * 2048 + k * 1024); } while (0)
#define PG8_MMA(ai, bj, At, Bt) do { __builtin_amdgcn_s_setprio(1); _Pragma("unroll") for (int m = 0; m < 4; ++m) _Pragma("unroll") for (int n = 0; n < 2; ++n) _Pragma("unroll") for (int k = 0; k < 2; ++k) \
        acc[ai][bj][m][n] = __builtin_amdgcn_mfma_f32_16x16x32_bf16(Bt[n][k], At[m][k], acc[ai][bj][m][n], 0, 0, 0); __builtin_amdgcn_s_setprio(0); } while (0)
#define PG8_WAIT_V(n) asm volatile("s_waitcnt vmcnt(" #n ")" ::: "memory")
#define PG8_WAIT_L(n) asm volatile("s_waitcnt lgkmcnt(" #n ")" ::: "memory")
#define PG8_BAR __builtin_amdgcn_s_barrier()
#define PG8_SCHED __builtin_amdgcn_sched_barrier(0)
    Unit cur, nxt; int ui = 0;
    if (!S.next(0, cur)) return;
    f32x4 acc[2][2][4][2];
#pragma unroll
    for (int a = 0; a < 2; ++a)
#pragma unroll
        for (int b = 0; b < 2; ++b)
#pragma unroll
            for (int m = 0; m < 4; ++m)
#pragma unroll
                for (int n = 0; n < 2; ++n) acc[a][b][m][n] = (f32x4){0.f, 0.f, 0.f, 0.f};
    bf16x8 At[4][2], B0[2][2], B1[2][2];
    const char* cA = (const char*)g.A + (size_t)cur.pm * tstepA; const char* cB = (const char*)g.Bt + (size_t)cur.pn * tstepB;
    S.a_ready(cur);
    if constexpr (SP2) {
        PG8_STAGE(PG8_SB(0, 0), cB, voffB); PG8_STAGE(PG8_SB(0, 1), cB + hstepB, voffB); PG8_STAGE(PG8_SA(0, 0), cA, voffA); PG8_STAGE(PG8_SA(0, 1), cA + hstepA, voffA);
        if (wr == 1) PG8_BAR;
        PG8_WAIT_V(2); PG8_BAR;
        PG8_STAGE(PG8_SB(1, 0), cB + kstep, voffB); PG8_STAGE(PG8_SA(1, 0), cA + kstep, voffA); PG8_STAGE(PG8_SB(1, 1), cB + hstepB + kstep, voffB);
        PG8_WAIT_V(6); PG8_BAR;
    } else {
        PG8_STAGE(PG8_SB(0, 0), cB, voffB); PG8_STAGE(PG8_SA(0, 0), cA, voffA); PG8_STAGE(PG8_SB(0, 1), cB + hstepB, voffB); PG8_STAGE(PG8_SA(0, 1), cA + hstepA, voffA);
        if (wr == 1) PG8_BAR;
        PG8_WAIT_V(4); PG8_BAR;
        PG8_STAGE(PG8_SB(1, 0), cB + kstep, voffB); PG8_STAGE(PG8_SA(1, 0), cA + kstep, voffA); PG8_STAGE(PG8_SB(1, 1), cB + hstepB + kstep, voffB);
        PG8_WAIT_V(6); PG8_BAR;
    }
    for (;;) {
        const bool has_next = S.next(ui + 1, nxt);
        const char* nA = has_next ? (const char*)g.A + (size_t)nxt.pm * tstepA : cA; const char* nB = has_next ? (const char*)g.Bt + (size_t)nxt.pn * tstepB : cB;
        for (int t = 0; t < nt; t += 2) {
            const bool last = (t == nt - 2);
            const char* a1 = cA + (size_t)(t + 1) * kstep;
            const char* a2 = last ? nA : cA + (size_t)(t + 2) * kstep; const char* b2 = last ? nB : cB + (size_t)(t + 2) * kstep;
            const char* a3 = a2 + kstep; const char* b3 = b2 + kstep;
            if (last && has_next) S.a_ready(nxt);
            if constexpr (SP2) {
            PG8_LDB(B0, 0, 0); PG8_LDB(B1, 0, 1); PG8_SCHED; PG8_LDA(At, 0, 0); PG8_STAGE(PG8_SA(1, 1), a1 + hstepA, voffA);
            PG8_WAIT_V(8); PG8_WAIT_L(0); PG8_BAR; PG8_MMA(0, 0, At, B0); PG8_MMA(0, 1, At, B1); PG8_BAR; PG8_SCHED;
            PG8_LDA(At, 0, 1); PG8_STAGE(PG8_SB(0, 0), b2, voffB); PG8_STAGE(PG8_SB(0, 1), b2 + hstepB, voffB); PG8_STAGE(PG8_SA(0, 0), a2, voffA);
            PG8_WAIT_V(8); PG8_WAIT_L(0); PG8_BAR; PG8_MMA(1, 0, At, B0); PG8_MMA(1, 1, At, B1); PG8_BAR; PG8_SCHED;
            PG8_LDB(B0, 1, 0); PG8_LDB(B1, 1, 1); PG8_SCHED; PG8_LDA(At, 1, 0); PG8_STAGE(PG8_SA(0, 1), a2 + hstepA, voffA);
            PG8_WAIT_V(8); PG8_WAIT_L(0); PG8_BAR; PG8_MMA(0, 0, At, B0); PG8_MMA(0, 1, At, B1); PG8_BAR; PG8_SCHED;
            PG8_LDA(At, 1, 1); PG8_STAGE(PG8_SB(1, 0), b3, voffB); PG8_STAGE(PG8_SB(1, 1), b3 + hstepB, voffB); PG8_STAGE(PG8_SA(1, 0), a3, voffA);
            PG8_WAIT_V(8); PG8_WAIT_L(0); PG8_BAR; PG8_MMA(1, 0, At, B0); PG8_MMA(1, 1, At, B1); PG8_BAR; PG8_SCHED;
            } else {
            PG8_LDB(B0, 0, 0); PG8_SCHED; PG8_LDA(At, 0, 0); PG8_STAGE(PG8_SA(1, 1), a1 + hstepA, voffA);
            PG8_WAIT_L(8); PG8_BAR; PG8_WAIT_L(0); PG8_MMA(0, 0, At, B0); PG8_BAR; PG8_SCHED;
            PG8_LDB(B1, 0, 1); PG8_STAGE(PG8_SB(0, 0), b2, voffB);
            PG8_BAR; PG8_WAIT_L(0); PG8_MMA(0, 1, At, B1); PG8_BAR;
            PG8_LDA(At, 0, 1); PG8_STAGE(PG8_SA(0, 0), a2, voffA);
            PG8_BAR; PG8_WAIT_L(0); PG8_MMA(1, 0, At, B0); PG8_BAR; PG8_SCHED;
            PG8_STAGE(PG8_SB(0, 1), b2 + hstepB, voffB);
            PG8_WAIT_V(6); PG8_BAR; PG8_MMA(1, 1, At, B1); PG8_BAR;
            PG8_LDB(B0, 1, 0); PG8_SCHED; PG8_LDA(At, 1, 0); PG8_STAGE(PG8_SA(0, 1), a2 + hstepA, voffA);
            PG8_WAIT_L(8); PG8_BAR; PG8_WAIT_L(0); PG8_MMA(0, 0, At, B0); PG8_BAR; PG8_SCHED;
            PG8_LDB(B1, 1, 1); PG8_STAGE(PG8_SB(1, 0), b3, voffB);
            PG8_BAR; PG8_WAIT_L(0); PG8_MMA(0, 1, At, B1); PG8_BAR;
            PG8_LDA(At, 1, 1); PG8_STAGE(PG8_SA(1, 0), a3, voffA);
            PG8_BAR; PG8_WAIT_L(0); PG8_MMA(1, 0, At, B0); PG8_BAR; PG8_SCHED;
            PG8_STAGE(PG8_SB(1, 1), b3 + hstepB, voffB);
            PG8_WAIT_V(6); PG8_BAR; PG8_MMA(1, 1, At, B1); PG8_BAR;
            }
        }
        if constexpr (ALIGN_EPI) { if (wr == 0) PG8_BAR; }
        if constexpr (!Epi::AFTER_DRAIN) { E(acc, cur, wr, wc, fr, fq); S.done(cur); }
        if (!has_next) break;
#pragma unroll
        for (int a = 0; a < 2; ++a)
#pragma unroll
            for (int b = 0; b < 2; ++b)
#pragma unroll
                for (int m = 0; m < 4; ++m)
#pragma unroll
                    for (int n = 0; n < 2; ++n) acc[a][b][m][n] = (f32x4){0.f, 0.f, 0.f, 0.f};
        cur = nxt; cA = nA; cB = nB; ++ui;
        if constexpr (ALIGN_EPI) { if (wr == 1) PG8_BAR; }
    }
    PG8_WAIT_V(0);
    if constexpr (!ALIGN_EPI) { if (wr == 0) PG8_BAR; }
    PG8_BAR;
    if constexpr (Epi::AFTER_DRAIN) { E.fused(acc, cur, wr, wc, fr, fq, lds, wid, lane); S.done(cur); }
#undef PG8_SA
#undef PG8_SB
#undef PG8_STAGE
#undef PG8_LDA
#undef PG8_LDB
#undef PG8_MMA
#undef PG8_WAIT_V
#undef PG8_WAIT_L
#undef PG8_BAR
#undef PG8_SCHED
}
}

#define LAS __attribute__((address_space(3)))
#define GASP __attribute__((address_space(1)))
typedef unsigned short bf16;
typedef unsigned v4u __attribute__((ext_vector_type(4)));
typedef unsigned v2u __attribute__((ext_vector_type(2)));
typedef float f32x2 __attribute__((ext_vector_type(2)));
typedef float f32x4 __attribute__((ext_vector_type(4)));
typedef float f32x16 __attribute__((ext_vector_type(16)));
typedef short bf16x8 __attribute__((ext_vector_type(8)));

constexpr int NWAVES = 8, NTHR = 512;
constexpr int BATCH = 32, SEQ = 2048, DM = 1024, DEPTH = 2, TOK = BATCH * SEQ, FF = 2816, NMODC = 9216;
constexpr int TH = TOK / 2;
constexpr float EPS = 1e-6f;
constexpr float QS_G = 0.125f * 1.4426950408889634f;
constexpr float QS_M = 0.10206207261596575f * 1.4426950408889634f;
constexpr int LDS_BYTES = 147456;

constexpr size_t MiB = 1u << 20;
constexpr size_t WS_MOD = 0, WS_CS = 3 * MiB, WS_RSQ = WS_CS + 262144, WS_RSKV = WS_RSQ + 131072;
constexpr size_t WS_BAR = WS_RSKV + 131072;
constexpr size_t WS_WT = 4 * MiB, WS_U = 100 * MiB, WS_X = 228 * MiB;
constexpr size_t WS_HID = WS_X;
constexpr size_t ARENA = (size_t)8192 * FF * 2, AR_G = 0, AR_ZG = 16 * MiB, AR_ZM = 22 * MiB, AR_QRAW = 28 * MiB, AR_KVRAW = 34 * MiB;
static_assert(AR_KVRAW + (size_t)4096 * 1024 * 2 <= ARENA && 8 * ARENA == (size_t)TOK * FF * 2, "arena map");
constexpr size_t WS_Y = 580 * MiB;
constexpr size_t WS_QG = WS_Y, WS_KG = WS_Y + 32 * MiB, WS_VTG = WS_Y + 40 * MiB, WS_QM = WS_Y + 48 * MiB, WS_KM = WS_Y + 96 * MiB, WS_VTM = WS_Y + 144 * MiB,
                 WS_OM = WS_Y + 176 * MiB, WS_OG = WS_Y + 208 * MiB, WS_MG = WS_Y + 240 * MiB, WS_H = WS_Y + 304 * MiB  , WS_END = WS_Y + 432 * MiB;
static_assert(WS_HID + (size_t)TOK * FF * 2 <= WS_Y, "ws map");
constexpr size_t LW = 23625728;
static_assert(WS_WT + 2 * LW * 2 <= WS_U, "weights fit");

struct Frame {
    LAS unsigned char* lds;
    int tid, lane, wave, vcu, G, bx;
    int xid, xr, nx;
};

__device__ __forceinline__ float wave_sum(float v) {
#pragma unroll
    for (int o = 1; o < 64; o <<= 1) v += __shfl_xor(v, o);
    return v;
}
template <class T> __device__ __forceinline__ T* uni(T* p) {
    const unsigned long long v = (unsigned long long)p;
    const unsigned lo = __builtin_amdgcn_readfirstlane((unsigned)v), hi = __builtin_amdgcn_readfirstlane((unsigned)(v >> 32));
    return (T*)(((unsigned long long)hi << 32) | lo);
}
__device__ __forceinline__ float bf2f(bf16 v) { return __uint_as_float((unsigned)v << 16); }
__device__ __forceinline__ unsigned f2bf(float f) { unsigned u = __float_as_uint(f); return (u + 0x7fffu + ((u >> 16) & 1u)) >> 16; }
__device__ __forceinline__ unsigned pk2(float lo, float hi) { return f2bf(lo) | (f2bf(hi) << 16); }

__device__ __forceinline__ void mat_info(int mat, int& K, int& Nd, int& Ns, size_t& off, int& in_idx, int& gain_idx) {
    gain_idx = -1;
    switch (mat) {
        case 0: K = 1024; Nd = 5632; Ns = 5632; off = 0; in_idx = 5; break;
        case 1: K = 2816; Nd = 1024; Ns = 1024; off = 5767168; in_idx = 6; break;
        case 2: K = 1024; Nd = 3584; Ns = 3488; off = 8650752; in_idx = 8; break;
        case 3: K = 384; Nd = 768; Ns = 768; off = 12320768; in_idx = 10; gain_idx = 9; break;
        case 4: K = 256; Nd = 1024; Ns = 1024; off = 12615680; in_idx = 12; gain_idx = 11; break;
        case 5: K = 512; Nd = 1024; Ns = 1024; off = 12877824; in_idx = 17; break;
        case 6: K = 512; Nd = 1024; Ns = 1024; off = 13402112; in_idx = 18; break;
        case 7: K = 1024; Nd = 1024; Ns = 1024; off = 13926400; in_idx = 19; break;
        case 8: K = 1024; Nd = 5632; Ns = 5632; off = 14974976; in_idx = 21; break;
        default: K = 2816; Nd = 1024; Ns = 1024; off = 20742144; in_idx = 22; break;
    }
}
__device__ __forceinline__ int mat_items(int mat) {
    switch (mat) { case 0: case 8: return 2816; case 1: case 9: return 1408; case 2: return 1792; case 3: return 144; case 4: return 128; case 5: case 6: return 256; default: return 512; }
}
constexpr int ITEMS_PER_LAYER = 2816 + 1408 + 1792 + 144 + 128 + 256 + 256 + 512 + 2816 + 1408;

__device__ __forceinline__ void cvt_item(const float* W, int K, int Ns, int src0, const float* gain, float cscale, bf16* WT, int n0, int k0, LAS float* scr, int lane) {
    float v_[32];
#pragma unroll
    for (int i = 0; i < 32; ++i) {
        const int kk = 2 * i + (lane >> 5);
        v_[i] = 0.f;
        if (src0 >= 0) v_[i] = W[(size_t)(k0 + kk) * Ns + src0 + (lane & 31)];
    }
#pragma unroll
    for (int i = 0; i < 32; ++i) {
        const int kk = 2 * i + (lane >> 5);
        float v = v_[i] * cscale;
        if (gain) v *= gain[k0 + kk];
        scr[kk * 33 + (lane & 31)] = v;
    }
    asm volatile("s_waitcnt lgkmcnt(0)" ::: "memory");
    const int c = lane & 7;
#pragma unroll
    for (int j = 0; j < 4; ++j) {
        const int n = (lane >> 3) + 8 * j; const LAS float* s = scr + (8 * c) * 33 + n;
        v4u o; o.x = pk2(s[0 * 33], s[1 * 33]); o.y = pk2(s[2 * 33], s[3 * 33]); o.z = pk2(s[4 * 33], s[5 * 33]); o.w = pk2(s[6 * 33], s[7 * 33]);
        *(v4u*)(WT + (size_t)(n0 + n) * K + k0 + 8 * c) = o;
    }
    asm volatile("s_waitcnt lgkmcnt(0)" ::: "memory");
}

struct Args { const float* in[23]; float* out; unsigned char* ws; int pad[2]; };
__device__ __forceinline__ const float* in_sel(const Args& a, int idx) {
    switch (idx) {
        case 5: return uni(a.in[5]); case 6: return uni(a.in[6]); case 8: return uni(a.in[8]); case 9: return uni(a.in[9]); case 10: return uni(a.in[10]); case 11: return uni(a.in[11]); case 12: return uni(a.in[12]);
        case 17: return uni(a.in[17]); case 18: return uni(a.in[18]); case 19: return uni(a.in[19]); case 21: return uni(a.in[21]); default: return uni(a.in[22]);
    }
}
__device__ __forceinline__ void p0_prologue(Frame& F, const Args& A, unsigned char* ws) {
    LAS float* scr = (LAS float*)(F.lds + F.wave * 16384);
    const int gw = F.vcu * NWAVES + F.wave, NGW = F.G * NWAVES;
    bf16* WT = (bf16*)(ws + WS_WT);
    for (int it = gw; it < DEPTH * ITEMS_PER_LAYER; it += NGW) {
        const int l = it / ITEMS_PER_LAYER; int r = it % ITEMS_PER_LAYER; int mat = 0;
        for (;;) { const int n = mat_items(mat); if (r < n) break; r -= n; ++mat; }
        int K, Nd, Ns, in_idx, gain_idx; size_t off; mat_info(mat, K, Nd, Ns, off, in_idx, gain_idx);
        const int nblk = Nd / 32, kb = r / nblk, nb = r % nblk, n0 = nb * 32, k0 = kb * 64;
        int src0 = n0; float cscale = 1.0f;
        if (mat == 0 || mat == 8) { const int pn = n0 >> 8, rr = n0 & 255, bj = rr >> 7, cc = rr & 127; src0 = bj * FF + 128 * pn + cc; cscale = bj == 0 ? 1.4426950408889634f : 0.6931471805599453f; }
        else if (mat == 2) { src0 = (n0 < 2048) ? 1440 + n0 : (n0 < 2816) ? 672 + (n0 - 2048) : (n0 < 3488) ? (n0 - 2816) : -1; }
        const float* W = in_sel(A, in_idx) + (size_t)l * K * Ns;
        const float* gain = gain_idx >= 0 ? in_sel(A, gain_idx) + (size_t)l * K : nullptr;
        cvt_item(W, K, Ns, src0, gain, cscale, WT + (size_t)l * LW + off, n0, k0, scr, F.lane);
    }
    {
        f32x2* CS = (f32x2*)(ws + WS_CS);
        for (int idx = (F.vcu * NTHR + F.tid); idx < 2048 * 16; idx += F.G * NTHR) {
            const int pos = idx >> 4, i = idx & 15;
            const float inv = exp2f(-(float)i * (13.287712379549449f / 16.0f));
            const float ang = (float)pos * inv;
            const double rev = (double)ang * 0.15915494309189535;
            const float fr = (float)(rev - __builtin_rint(rev));
            CS[idx] = (f32x2){__builtin_amdgcn_cosf(fr), __builtin_amdgcn_sinf(fr)};
        }
    }
    __syncthreads();
    {
        LAS float* cs = (LAS float*)F.lds;
        const float* c = uni(A.in[1]);
        float* mod = (float*)(ws + WS_MOD);
        for (int it = F.vcu; it < DEPTH * (NMODC / 64); it += F.G) {
            for (int idx = F.tid; idx < 32 * 1024; idx += NTHR) { const int k = idx >> 5, b = idx & 31; const float v = c[b * 1024 + k]; cs[idx] = v / (1.0f + __expf(-v)); }
            __syncthreads();
            const int l = it / (NMODC / 64), jb = it % (NMODC / 64), col = jb * 64 + F.lane;
            const float* w = uni(A.in[2]) + (size_t)l * 1024 * NMODC + col;
            float acc[32];
#pragma unroll
            for (int b = 0; b < 32; ++b) acc[b] = 0.f;
            const int kbeg = F.wave * 128;
#pragma unroll 4
            for (int k = kbeg; k < kbeg + 128; ++k) {
                const float wv = w[(size_t)k * NMODC];
                const LAS f32x4* cr = (const LAS f32x4*)(cs + k * 32);
#pragma unroll
                for (int b4 = 0; b4 < 8; ++b4) { const f32x4 cv = cr[b4]; acc[4 * b4] += cv[0] * wv; acc[4 * b4 + 1] += cv[1] * wv; acc[4 * b4 + 2] += cv[2] * wv; acc[4 * b4 + 3] += cv[3] * wv; }
            }
            __syncthreads();
            LAS float* red = (LAS float*)F.lds;
#pragma unroll
            for (int b = 0; b < 32; ++b) red[(F.wave * 32 + b) * 64 + F.lane] = acc[b];
            __syncthreads();
#pragma unroll
            for (int q = 0; q < 4; ++q) {
                const int idx = F.tid + NTHR * q, b = idx >> 6, cc = idx & 63;
                float sum = uni(A.in[3])[(size_t)l * NMODC + jb * 64 + cc];
#pragma unroll
                for (int wv = 0; wv < 8; ++wv) sum += red[(wv * 32 + b) * 64 + cc];
                mod[((size_t)l * 32 + b) * NMODC + jb * 64 + cc] = sum;
            }
            __syncthreads();
        }
    }
}

template <int CTRL> __device__ __forceinline__ float dppf(float v) { return __builtin_bit_cast(float, __builtin_amdgcn_update_dpp(0, __builtin_bit_cast(int, v), CTRL, 0xF, 0xF, true)); }
__device__ __forceinline__ float row8_sum(float v) { v += dppf<0xB1>(v); v += dppf<0x4E>(v); v += dppf<0x141>(v); return v; }
__device__ __forceinline__ float row16_sum(float v) { v = row8_sum(v); v += dppf<0x140>(v); return v; }
__device__ __forceinline__ f32x4 ld4bf(const bf16* p) { const v2u w = *(const GASP v2u*)p; return (f32x4){__uint_as_float(w.x << 16), __uint_as_float(w.x & 0xffff0000u), __uint_as_float(w.y << 16), __uint_as_float(w.y & 0xffff0000u)}; }
__device__ __forceinline__ v2u pk4(f32x4 v) { v2u w; w.x = pk2(v[0], v[1]); w.y = pk2(v[2], v[3]); return w; }
__device__ __forceinline__ float dot4(f32x4 x) { return (x[0] * x[0] + x[1] * x[1]) + (x[2] * x[2] + x[3] * x[3]); }
__device__ __forceinline__ f32x4 rope4(f32x4 y, f32x4 cA, f32x4 cB, bool hi) {
    f32x4 p; p[0] = __shfl_xor(y[0], 4); p[1] = __shfl_xor(y[1], 4); p[2] = __shfl_xor(y[2], 4); p[3] = __shfl_xor(y[3], 4);
    if (!hi) p = -p;
    return (f32x4){y[0] * cA[0] + p[0] * cA[1], y[1] * cA[2] + p[1] * cA[3], y[2] * cB[0] + p[2] * cB[1], y[3] * cB[2] + p[3] * cB[3]};
}

__device__ __forceinline__ void norm_phase(Frame& F, const void* h, int h_bf, const float* gain, const float* sh, const float* sc, bf16* U) {
    const int lw = F.xr * NWAVES + F.wave, NLW = F.nx * NWAVES;
    for (int lb = lw; lb < 256; lb += NLW) {
        const int blk = 256 * F.xid + lb;
        const int m0 = blk * 32, b = m0 >> 11;
        f32x4 A[4], B[4];
#pragma unroll
        for (int j = 0; j < 4; ++j) {
            const int col = 256 * j + 4 * F.lane;
            A[j] = *(const GASP f32x4*)(gain + col) * (*(const GASP f32x4*)(sc + (size_t)b * NMODC + col) + 1.0f);
            B[j] = *(const GASP f32x4*)(sh + (size_t)b * NMODC + col);
        }
#pragma unroll 4
        for (int r = 0; r < 32; ++r) {
            const int m = m0 + r;
            f32x4 v[4]; float s = 0.f;
            if (h_bf) {
                const bf16* xr = (const bf16*)h + (size_t)m * DM + 4 * F.lane;
#pragma unroll
                for (int j = 0; j < 4; ++j) { v[j] = ld4bf(xr + 256 * j); s += dot4(v[j]); }
            } else {
                const f32x4* xr = (const f32x4*)((const float*)h + (size_t)m * DM) + F.lane;
#pragma unroll
                for (int j = 0; j < 4; ++j) { v[j] = *(const GASP f32x4*)(xr + 64 * j); s += dot4(v[j]); }
            }
            s = row16_sum(s); s += __shfl_xor(s, 16); s += __shfl_xor(s, 32);
            const float rstd = rsqrtf(s * (1.f / DM) + EPS);
            v2u* o8 = (v2u*)(U + (size_t)m * DM) + F.lane;
#pragma unroll
            for (int j = 0; j < 4; ++j) *(GASP v2u*)(o8 + 64 * j) = pk4(v[j] * rstd * A[j] + B[j]);
        }
    }
}

__device__ __forceinline__ void pp1_phase(Frame& F, unsigned char* ws, const bf16* ZG, const bf16* ZM, const float* gqn, const float* gkn) {
    float* RSQ = (float*)(ws + WS_RSQ); float* RSKV = (float*)(ws + WS_RSKV);
    bf16* QG = (bf16*)(ws + WS_QG); bf16* KG = (bf16*)(ws + WS_KG); bf16* VTG = (bf16*)(ws + WS_VTG);
    const float* CS = (const float*)(ws + WS_CS);
    const int lane = F.lane, a = lane & 15;
    const f32x4 gq4 = *(const GASP f32x4*)(gqn + 4 * a), gk4 = *(const GASP f32x4*)(gkn + 4 * a);
    const bool hi = (a & 4) != 0;
    LAS bf16* stage = (LAS bf16*)F.lds;
    for (int lc = F.xr; lc < 64; lc += F.nx) {
        const int ch = 64 * F.xid + lc;
        const int lr0 = ch * 64, bl = lr0 >> 11, s0 = lr0 & 2047;
#pragma unroll 2
        for (int i = 0; i < 8; ++i) {
            const int tk = F.wave * 8 + i, lr = lr0 + tk, s = s0 + tk;
            const bf16* zg = ZG + (size_t)lr * 768; const bf16* zm = ZM + (size_t)lr * 768;
            float ss = dot4(ld4bf(zm + 4 * lane)); if (lane < 32) ss += dot4(ld4bf(zm + 256 + 4 * lane));
            ss = wave_sum(ss); if (lane == 0) RSQ[lr] = rsqrtf(ss * (1.f / 384.f) + EPS);
            ss = wave_sum(dot4(ld4bf(zm + 384 + 4 * lane))); if (lane == 0) RSKV[lr] = rsqrtf(ss * (1.f / 256.f) + EPS);
            const int pos = (a < 8) ? (s >> 6) : (s & 63);
            const f32x4 cA = *(const GASP f32x4*)(CS + (pos * 16 + 4 * (a & 3)) * 2), cB = *(const GASP f32x4*)(CS + (pos * 16 + 4 * (a & 3)) * 2 + 4);
#pragma unroll
            for (int j = 0; j < 3; ++j) {
                const v2u raw = *(const GASP v2u*)(zg + 256 * j + 4 * lane);
                const f32x4 x = (f32x4){__uint_as_float(raw.x << 16), __uint_as_float(raw.x & 0xffff0000u), __uint_as_float(raw.y << 16), __uint_as_float(raw.y & 0xffff0000u)};
                const float q = row16_sum(dot4(x));
                const float r = rsqrtf(q * (1.f / 64.f) + EPS);
                const f32x4 o = rope4(x * r * (j < 2 ? gq4 : gk4), cA, cB, hi);
                if (j < 2) *(GASP v2u*)(QG + (size_t)lr * 512 + 256 * j + 4 * lane) = pk4(o * QS_G);
                else if (lane < 32) *(GASP v2u*)(KG + (size_t)lr * 128 + 4 * lane) = pk4(o);
                else *(LAS v2u*)(stage + tk * 132 + 4 * (lane - 32)) = raw;
            }
        }
        __syncthreads();
#pragma unroll
        for (int jj = 0; jj < 2; ++jj) {
            const int it = F.tid + 512 * jj, hd = it >> 3, cc = it & 7;
            unsigned e[8];
#pragma unroll
            for (int j = 0; j < 8; ++j) e[j] = stage[(8 * cc + j) * 132 + hd];
            v4u o; o.x = e[0] | (e[1] << 16); o.y = e[2] | (e[3] << 16); o.z = e[4] | (e[5] << 16); o.w = e[6] | (e[7] << 16);
            *(GASP v4u*)(VTG + ((size_t)(bl * 128 + hd)) * 2048 + s0 + 8 * cc) = o;
        }
        __syncthreads();
    }
}

__device__ __forceinline__ void pp2_phase(Frame& F, unsigned char* ws, const bf16* QRAW, const bf16* KVRAW, const bf16* ZM, const float* gqn, const float* gkn) {
    bf16* QM = (bf16*)(ws + WS_QM); bf16* KM = (bf16*)(ws + WS_KM); bf16* VTM = (bf16*)(ws + WS_VTM);
    const float* CS = (const float*)(ws + WS_CS);
    const int lane = F.lane, a = lane & 15, hh = lane >> 4, a8 = lane & 7, h8 = lane >> 3;
    const f32x4 g0q = *(const GASP f32x4*)(gqn + 4 * a), g1q = *(const GASP f32x4*)(gqn + 64 + 4 * a8), g0k = *(const GASP f32x4*)(gkn + 4 * a), g1k = *(const GASP f32x4*)(gkn + 64 + 4 * a8);
    const bool hi = (a8 & 4) != 0;
    LAS bf16* stage = (LAS bf16*)F.lds;
    for (int lc = F.xr; lc < 64; lc += F.nx) {
        const int ch = 64 * F.xid + lc;
        const int lr0 = ch * 64, bl = lr0 >> 11, s0 = lr0 & 2047;
#pragma unroll 2
        for (int i = 0; i < 8; ++i) {
            const int tk = F.wave * 8 + i, lr = lr0 + tk, s = s0 + tk;
            const bf16* qr = QRAW + (size_t)lr * 768; const bf16* kvr = KVRAW + (size_t)lr * 1024; const bf16* zm = ZM + (size_t)lr * 768;
            const f32x4 cA = *(const GASP f32x4*)(CS + (s * 16 + 4 * (a8 & 3)) * 2), cB = *(const GASP f32x4*)(CS + (s * 16 + 4 * (a8 & 3)) * 2 + 4);
            {
                const f32x4 xr = ld4bf(qr + 96 * h8 + 64 + 4 * a8);
                const float ssr = row8_sum(dot4(xr));
                float rp[2];
#pragma unroll
                for (int p = 0; p < 2; ++p) {
                    const f32x4 xn = ld4bf(qr + 96 * (4 * p + hh) + 4 * a);
                    const float ssn = row16_sum(dot4(xn));
                    const float ssrh = __shfl(ssr, 32 * p + 8 * hh);
                    const float r = rsqrtf((ssn + ssrh) * (1.f / 96.f) + EPS); rp[p] = r;
                    *(GASP v2u*)(QM + (size_t)lr * 768 + 96 * (4 * p + hh) + 4 * a) = pk4(xn * g0q * (r * QS_M));
                }
                const float r0 = __shfl(rp[0], 16 * (h8 & 3)), r1 = __shfl(rp[1], 16 * (h8 & 3));
                const float rr = (h8 < 4) ? r0 : r1;
                const f32x4 o = rope4(xr * g1q * rr, cA, cB, hi);
                *(GASP v2u*)(QM + (size_t)lr * 768 + 96 * h8 + 64 + 4 * a8) = pk4(o * QS_M);
            }
            {
                const f32x4 kr = ld4bf(zm + 640 + 4 * a8);
                const float sspe = row8_sum(dot4(kr));
                float rp[2];
#pragma unroll
                for (int p = 0; p < 2; ++p) {
                    const f32x4 xn = ld4bf(kvr + 128 * (4 * p + hh) + 4 * a);
                    const float ssn = row16_sum(dot4(xn));
                    const float r = rsqrtf((ssn + sspe) * (1.f / 96.f) + EPS); rp[p] = r;
                    *(GASP v2u*)(KM + (size_t)lr * 768 + 96 * (4 * p + hh) + 4 * a) = pk4(xn * g0k * r);
                    *(LAS v2u*)(stage + tk * 516 + 64 * (4 * p + hh) + 4 * a) = *(const GASP v2u*)(kvr + 128 * (4 * p + hh) + 64 + 4 * a);
                }
                const float r0 = __shfl(rp[0], 16 * (h8 & 3)), r1 = __shfl(rp[1], 16 * (h8 & 3));
                const float rr = (h8 < 4) ? r0 : r1;
                const f32x4 o = rope4(kr * g1k * rr, cA, cB, hi);
                *(GASP v2u*)(KM + (size_t)lr * 768 + 96 * h8 + 64 + 4 * a8) = pk4(o);
            }
        }
        __syncthreads();
#pragma unroll 2
        for (int jj = 0; jj < 8; ++jj) {
            const int it = F.tid + 512 * jj, hd = it >> 3, cc = it & 7;
            unsigned e[8];
#pragma unroll
            for (int j = 0; j < 8; ++j) e[j] = stage[(8 * cc + j) * 516 + hd];
            v4u o; o.x = e[0] | (e[1] << 16); o.y = e[2] | (e[3] << 16); o.z = e[4] | (e[5] << 16); o.w = e[6] | (e[7] << 16);
            *(GASP v4u*)(VTM + ((size_t)(bl * 512 + hd)) * 2048 + s0 + 8 * cc) = o;
        }
        __syncthreads();
    }
}

typedef __bf16 bf16x2_t __attribute__((ext_vector_type(2)));
__device__ __forceinline__ unsigned cvtpk(float lo, float hi) { const f32x2 v = {lo, hi}; const bf16x2_t b = __builtin_convertvector(v, bf16x2_t); return __builtin_bit_cast(unsigned, b); }
#define ATT_BAR() asm volatile("s_waitcnt lgkmcnt(0)\n\ts_barrier" ::: "memory")
template <int DQ>
__device__ __forceinline__ void attn_unit(LAS unsigned char* lds, const bf16* Qp, int ldq, const bf16* Kp, int ldk, const bf16* Vtp, bf16* Op, int tid, int lane, int wave) {
    constexpr int KP = DQ * 2 + 16, VP = 144, KBUF = 64 * KP, VBUF = 64 * VP, ND = DQ / 16, KCH = DQ / 8, NKC = 64 * KCH, NT = SEQ / 64;
    constexpr bool K2 = NKC > 512;
    constexpr float THR = 8.0f;
    const int q = lane & 31, hi = lane >> 5;
    bf16x8 qf[ND];
#pragma unroll
    for (int d0 = 0; d0 < ND; ++d0) qf[d0] = *(const GASP bf16x8*)(Qp + (size_t)(wave * 32 + q) * ldq + d0 * 16 + hi * 8);
    const int kr0 = tid / KCH, kc0 = tid % KCH, kr1 = (tid + 512) / KCH, kc1 = (tid + 512) % KCH;
    const bool k1v = K2 && (tid + 512 < NKC);
    const unsigned kg0 = (unsigned)(kr0 * ldk + kc0 * 8) * 2u;
    const unsigned kg1 = (unsigned)((k1v ? kr1 : 0) * ldk + (k1v ? kc1 : 0) * 8) * 2u;
    const int vd = tid >> 3, vc = tid & 7;
    const unsigned vg = (unsigned)(vd * 2048 + vc * 8) * 2u;
    const int ks0 = kr0 * KP + kc0 * 16, ks1 = kr1 * KP + kc1 * 16, vs = 2 * KBUF + vd * VP + vc * 16;
    const int pq = (q & 0x13) | ((q & 4) << 1) | ((q & 8) >> 1);
    const int ka = pq * KP + hi * 16, va = 2 * KBUF + q * VP + hi * 16;
#define LOADK(R, tile) do { const char* kt_ = (const char*)(Kp + (size_t)(tile) * 64 * ldk); R##_k0 = *(const GASP v4u*)(kt_ + kg0); if (K2) { if (k1v) R##_k1 = *(const GASP v4u*)(kt_ + kg1); } } while (0)
#define LOADV(R, tile) do { R##_v = *(const GASP v4u*)((const char*)(Vtp + (tile) * 64) + vg); } while (0)
#define STOREK(R, buf) do { *(LAS v4u*)(lds + (buf) * KBUF + ks0) = R##_k0; if (K2) { if (k1v) *(LAS v4u*)(lds + (buf) * KBUF + ks1) = R##_k1; } } while (0)
#define STOREV(R, buf) do { *(LAS v4u*)(lds + (buf) * VBUF + vs) = R##_v; } while (0)
#define QKT(S0, S1, buf, C0, C1) do { const LAS unsigned char* Kb_ = lds + (buf) * KBUF + ka; \
        _Pragma("unroll") for (int d0 = 0; d0 < ND; ++d0) { \
            const bf16x8 a0_ = *(const LAS bf16x8*)(Kb_ + d0 * 32), a1_ = *(const LAS bf16x8*)(Kb_ + 32 * KP + d0 * 32); \
            S0 = __builtin_amdgcn_mfma_f32_32x32x16_bf16(a0_, qf[d0], d0 == 0 ? C0 : S0, 0, 0, 0); \
            S1 = __builtin_amdgcn_mfma_f32_32x32x16_bf16(a1_, qf[d0], d0 == 0 ? C1 : S1, 0, 0, 0); } } while (0)
#define PVT(buf) do { const LAS unsigned char* Vb_ = lds + (buf) * VBUF + va; \
        _Pragma("unroll") for (int jj = 0; jj < 4; ++jj) { \
            const bf16x8 v0_ = *(const LAS bf16x8*)(Vb_ + jj * 32), v1_ = *(const LAS bf16x8*)(Vb_ + 32 * VP + jj * 32); \
            const bf16x8 pf_ = __builtin_bit_cast(bf16x8, pw[jj]); \
            o0 = __builtin_amdgcn_mfma_f32_32x32x16_bf16(v0_, pf_, o0, 0, 0, 0); \
            o1 = __builtin_amdgcn_mfma_f32_32x32x16_bf16(v1_, pf_, o1, 0, 0, 0); } } while (0)
    v4u a_k0, a_k1 = (v4u){0u, 0u, 0u, 0u}, a_v, b_k0, b_k1 = (v4u){0u, 0u, 0u, 0u}, b_v;
    LOADK(a, 0); LOADK(b, 1); LOADV(a, 0);
    STOREK(a, 0); STOREK(b, 1); STOREV(a, 1);
    LOADK(a, 2); LOADK(b, 3); LOADV(b, 1);
    ATT_BAR();
    f32x16 zero16, sc0, sc1, sn0, sn1, o0, o1, negm;
#pragma unroll
    for (int r = 0; r < 16; ++r) { zero16[r] = 0.f; o0[r] = 0.f; o1[r] = 0.f; }
    QKT(sc0, sc1, 0, zero16, zero16);
    float l_run = 0.f;
    {
        float mx = fmaxf(sc0[0], sc1[0]);
#pragma unroll
        for (int r = 1; r < 16; ++r) mx = fmaxf(mx, fmaxf(sc0[r], sc1[r]));
        mx = fmaxf(mx, __shfl_xor(mx, 32));
#pragma unroll
        for (int r = 0; r < 16; ++r) { sc0[r] -= mx; sc1[r] -= mx; negm[r] = -mx; }
    }
    v4u pw[4];
#pragma unroll
    for (int jj = 0; jj < 4; ++jj) pw[jj] = (v4u){0u, 0u, 0u, 0u};
#define FRAG_ADDR(i, BQ, BP) (((i) < 2 * ND) ? (lds + (BQ) * KBUF + ka + ((i) & 1) * 32 * KP + ((i) >> 1) * 32) \
                                             : (lds + (BP) * VBUF + va + (((i) - 2 * ND) & 1) * 32 * VP + (((i) - 2 * ND) >> 1) * 32))
#define SLICE(k, SC0, SC1, PW) do { \
        float e0_, e1_; \
        if ((k) < 8) { e0_ = __builtin_amdgcn_exp2f(SC0[2 * (k)]); e1_ = __builtin_amdgcn_exp2f(SC0[2 * (k) + 1]); } \
        else { e0_ = __builtin_amdgcn_exp2f(SC1[2 * (k) - 16]); e1_ = __builtin_amdgcn_exp2f(SC1[2 * (k) - 15]); } \
        lsA_ += e0_; lsB_ += e1_; \
        unsigned w_ = cvtpk(e0_, e1_); asm volatile("" : "+v"(w_), "+v"(lsA_), "+v"(lsB_)); PW[(k) >> 2][(k) & 3] = w_; \
    } while (0)
#define STAGE(t, R, BQ, BP, BS, PR, PW, SC0, SC1, SN0, SN1) do { \
        constexpr int NQ_ = 2 * ND, NM_ = NQ_ + 8; \
        constexpr int FD_ = 3, FR_ = FD_ + 1, SL0_ = 3;     \
        bf16x8 fr_[FR_]; \
        _Pragma("unroll") for (int i = 0; i < FD_; ++i) fr_[i] = *(const LAS bf16x8*)FRAG_ADDR(i, BQ, BP); \
        float lsA_ = 0.f, lsB_ = 0.f, mx_ = -INFINITY; \
        _Pragma("unroll") for (int k = 0; k < SL0_; ++k) { SLICE(k, SC0, SC1, PW); } \
        __builtin_amdgcn_sched_barrier(0); \
        _Pragma("unroll") for (int i = 0; i < NM_; ++i) { \
            if (i + FD_ < NM_) fr_[(i + FD_) % FR_] = *(const LAS bf16x8*)FRAG_ADDR(i + FD_, BQ, BP); \
            if (i < NQ_) { \
                const int d0_ = i >> 1; \
                if ((i & 1) == 0) SN0 = __builtin_amdgcn_mfma_f32_32x32x16_bf16(fr_[i % FR_], qf[d0_], d0_ == 0 ? negm : SN0, 0, 0, 0); \
                else              SN1 = __builtin_amdgcn_mfma_f32_32x32x16_bf16(fr_[i % FR_], qf[d0_], d0_ == 0 ? negm : SN1, 0, 0, 0); \
            } else { \
                const int j_ = i - NQ_; const bf16x8 pf_ = __builtin_bit_cast(bf16x8, PR[j_ >> 1]); \
                if ((j_ & 1) == 0) o0 = __builtin_amdgcn_mfma_f32_32x32x16_bf16(fr_[i % FR_], pf_, o0, 0, 0, 0); \
                else               o1 = __builtin_amdgcn_mfma_f32_32x32x16_bf16(fr_[i % FR_], pf_, o1, 0, 0, 0); \
            } \
            if (i + SL0_ < 16) { SLICE(i + SL0_, SC0, SC1, PW); }                  \
            if (i >= NM_ - 6) { \
                _Pragma("unroll") for (int r = 3 * (i - (NM_ - 6)); r < 3 * (i - (NM_ - 6)) + 3; ++r) if (r < 16) mx_ = fmaxf(fmaxf(mx_, SN0[r]), SN1[r]); \
                asm volatile("" : "+v"(mx_)); \
            } \
            if (i == 13) { STOREK(R, BS); }                    \
            if (i == 14) { STOREV(R, BS); } \
            if (i == 15) { const int tk_ = ((t) + 4 < NT) ? (t) + 4 : NT - 1, tv_ = ((t) + 2 < NT) ? (t) + 2 : NT - 1; LOADK(R, tk_); LOADV(R, tv_); } \
            __builtin_amdgcn_sched_barrier(0); \
        } \
        l_run = l_run * al_pend + (lsA_ + lsB_); \
        ATT_BAR(); \
        if (pend) { _Pragma("unroll") for (int r = 0; r < 16; ++r) { o0[r] *= al_pend; o1[r] *= al_pend; } } \
        pend = false; al_pend = 1.0f; \
        if (__any(mx_ > THR)) { \
            const float rm_ = fmaxf(mx_, __shfl_xor(mx_, 32)); \
            const float dl_ = fmaxf(rm_, 0.f); \
            al_pend = __builtin_amdgcn_exp2f(-dl_); pend = true; \
            _Pragma("unroll") for (int r = 0; r < 16; ++r) { SN0[r] -= dl_; SN1[r] -= dl_; negm[r] -= dl_; } \
        } \
    } while (0)
    float al_pend = 1.0f; bool pend = false;
    v4u pw2[4];
    for (int t = 0; t < NT; t += 2) {
        STAGE(t, a, 1, 1, 0, pw, pw2, sc0, sc1, sn0, sn1);
        STAGE(t + 1, b, 0, 0, 1, pw2, pw, sn0, sn1, sc0, sc1);
    }
#undef FRAG_ADDR
#undef SLICE
    PVT(1);
    l_run += __shfl_xor(l_run, 32);
    const float inv = __builtin_amdgcn_rcpf(l_run);
    bf16* orow = Op + (size_t)(wave * 32 + q) * 512 + 4 * hi;
#pragma unroll
    for (int a = 0; a < 4; ++a) {
        v2u w0, w1;
        w0.x = cvtpk(o0[4 * a] * inv, o0[4 * a + 1] * inv); w0.y = cvtpk(o0[4 * a + 2] * inv, o0[4 * a + 3] * inv);
        w1.x = cvtpk(o1[4 * a] * inv, o1[4 * a + 1] * inv); w1.y = cvtpk(o1[4 * a + 2] * inv, o1[4 * a + 3] * inv);
        *(GASP v2u*)(orow + 8 * a) = w0; *(GASP v2u*)(orow + 32 + 8 * a) = w1;
    }
    ATT_BAR();
#undef LOADK
#undef LOADV
#undef STOREK
#undef STOREV
#undef QKT
#undef PVT
#undef STAGE
}

__device__ __forceinline__ void attn_phase(Frame& F, unsigned char* ws) {
    const bf16* QM = (const bf16*)(ws + WS_QM); const bf16* KM = (const bf16*)(ws + WS_KM); const bf16* VTM = (const bf16*)(ws + WS_VTM); bf16* OM = (bf16*)(ws + WS_OM);
    const bf16* QG = (const bf16*)(ws + WS_QG); const bf16* KG = (const bf16*)(ws + WS_KG); const bf16* VTG = (const bf16*)(ws + WS_VTG); bf16* OG = (bf16*)(ws + WS_OG);
    constexpr int NU = 16 * 8 * 8;
    for (int lu = F.xr; lu < 256; lu += F.nx) {
        const int U = (lu < 128) ? (2 * F.xid) * 64 + lu : NU + (2 * F.xid) * 64 + (lu - 128);
        int tid_ = F.tid; asm volatile("" : "+v"(tid_));
        const int lane_ = tid_ & 63, wave_ = __builtin_amdgcn_readfirstlane(tid_ >> 6);
        if (U < NU) {
            const int qb = U & 7, h = (U >> 3) & 7, bl = U >> 6;
            const size_t r0 = (size_t)bl * 2048;
            attn_unit<96>(F.lds, QM + (r0 + qb * 256) * 768 + h * 96, 768, KM + r0 * 768 + h * 96, 768, VTM + (size_t)((bl * 8 + h) * 64) * 2048, OM + (r0 + qb * 256) * 512 + h * 64, tid_, lane_, wave_);
        } else {
            const int u = U - NU, qb = u & 7, hq = (u >> 3) & 7, bl = u >> 6, kvh = hq >> 2;
            const size_t r0 = (size_t)bl * 2048;
            attn_unit<64>(F.lds, QG + (r0 + qb * 256) * 512 + hq * 64, 512, KG + r0 * 128 + kvh * 64, 128, VTG + (size_t)((bl * 2 + kvh) * 64) * 2048, OG + (r0 + qb * 256) * 512 + hq * 64, tid_, lane_, wave_);
        }
    }
}

typedef __attribute__((address_space(1))) unsigned gu32;
#define XB_TMO      128
#define XB_XCNT(j)  (256  + 64 * (j))
#define XB_XSUB(j)  (1280 + 64 * (j))
#define XB_XGEN(j)  (2304 + 64 * (j))
#define XB_TOP      3328
#define XB_TOPGEN   3392
#define XCD_BAR_WORDS 3456
#define XB_SPIN_CAP (1u << 18)

__device__ __forceinline__ unsigned xb_ld(unsigned* p)              { return __hip_atomic_load(p, __ATOMIC_RELAXED, __HIP_MEMORY_SCOPE_AGENT); }
__device__ __forceinline__ unsigned xb_add(unsigned* p, unsigned v) { return __hip_atomic_fetch_add(p, v, __ATOMIC_RELAXED, __HIP_MEMORY_SCOPE_AGENT); }
__device__ __forceinline__ unsigned xb_xcc_id() { return (unsigned)__builtin_amdgcn_s_getreg((3 << 11) | 20) & 0xFu; }
#define XB_SPIN(cond, bar) do { unsigned _sp = 0; while (cond) { __builtin_amdgcn_s_sleep(1); \
    if ((++_sp & 255u) == 0u) { if (xb_ld(&(bar)[XB_TMO])) break; if (_sp > XB_SPIN_CAP) { atomicAdd(&(bar)[XB_TMO], 1u); break; } } } } while (0)

struct XcdBarrier {
    unsigned* bar; unsigned x;
    volatile LAS unsigned* st;
};

__device__ __forceinline__ XcdBarrier xcd_barrier_post(unsigned* bar, volatile LAS unsigned* st) {
    XcdBarrier b; b.bar = bar; b.x = xb_xcc_id(); b.st = st;
    if (threadIdx.x == 0) (void)xb_add(&bar[XB_XCNT(b.x)], 1u);
    return b;
}
__device__ __forceinline__ void xcd_barrier_complete(unsigned* bar, unsigned x, unsigned& nloc, unsigned& nx) {
    const unsigned G = gridDim.x * gridDim.y * gridDim.z;
    unsigned sum, cnt, mine, sp = 0u;
    for (;;) {
        sum = 0u; cnt = 0u; mine = 0u;
#pragma unroll
        for (unsigned j = 0; j < 16; ++j) { const unsigned c = xb_ld(&bar[XB_XCNT(j)]); sum += c; cnt += (c > 0u) ? 1u : 0u; mine = (j == x) ? c : mine; }
        if (sum == G) break;
        __builtin_amdgcn_s_sleep(1);
        if ((++sp & 255u) == 0u) { if (xb_ld(&bar[XB_TMO])) break; if (sp > XB_SPIN_CAP) { atomicAdd(&bar[XB_TMO], 1u); break; } }
    }
    nloc = mine > 0u ? mine : 1u; nx = cnt > 0u ? cnt : 1u;
}

__device__ __forceinline__ void xcd_barrier(const XcdBarrier& b) {
    asm volatile("s_waitcnt vmcnt(0)" ::: "memory");
    __syncthreads();
    if (threadIdx.x == 0) {
        unsigned* bar = b.bar;
        __builtin_amdgcn_s_waitcnt(0);
        unsigned nloc = b.st[0], nx = b.st[1];
        if (nloc == 0u) { xcd_barrier_complete(bar, b.x, nloc, nx); b.st[0] = nloc; b.st[1] = nx; }
        const unsigned old = xb_add(&bar[XB_XSUB(b.x)], 1u);
        const unsigned gen = old / nloc;
        if (old + 1u == (gen + 1u) * nloc) {
            __builtin_amdgcn_fence(__ATOMIC_RELEASE, "agent");
            asm volatile("s_waitcnt vmcnt(0)" ::: "memory");
            const unsigned og = xb_add(&bar[XB_TOP], 1u);
            const unsigned tg = og / nx;
            if (og + 1u == (tg + 1u) * nx) xb_add(&bar[XB_TOPGEN], 1u);
            else XB_SPIN(xb_ld(&bar[XB_TOPGEN]) == tg, bar);
            __builtin_amdgcn_fence(__ATOMIC_ACQUIRE, "agent");
            xb_add(&bar[XB_XGEN(b.x)], 1u);
            asm volatile("s_waitcnt vmcnt(0)" ::: "memory");
        } else {
            XB_SPIN(xb_ld(&bar[XB_XGEN(b.x)]) == gen, bar);
            __builtin_amdgcn_fence(__ATOMIC_ACQUIRE, "agent");
            asm volatile("s_waitcnt vmcnt(0)" ::: "memory");
        }
    }
    __syncthreads();
}

#define LB_SUB(j) (XCD_BAR_WORDS + 64 * (j))
#define LB_GEN(j) (XCD_BAR_WORDS + 512 + 64 * (j))
__device__ __forceinline__ void xcd_local_barrier(unsigned* bar, unsigned x, unsigned nx) {
    asm volatile("s_waitcnt vmcnt(0)" ::: "memory");
    __syncthreads();
    if (threadIdx.x == 0) {
        const unsigned old = xb_add(&bar[LB_SUB(x)], 1u);
        const unsigned gen = old / nx;
        if (old + 1u == (gen + 1u) * nx) xb_add(&bar[LB_GEN(x)], 1u);
        else XB_SPIN(xb_ld(&bar[LB_GEN(x)]) == gen, bar);
        __builtin_amdgcn_fence(__ATOMIC_ACQUIRE, "agent");
        asm volatile("s_waitcnt vmcnt(0)" ::: "memory");
    }
    __syncthreads();
}

template <class Epi>
__device__ __forceinline__ void run_gemm(Frame& F, const bf16* A, int lda, const bf16* Bt, int pm0, int LP, int N, int K, const Epi& E, int rev = 0) {
    pg8::Gemm g{A, Bt, TOK, N, K, lda}; pg8::XcdOrder S; S.init(pm0, LP, N, F.xr, F.nx, rev);
    pg8::gemm_phase<Epi, pg8::XcdOrder, true, true>(F.lds, g, S, E, F.tid);
}

constexpr int STEPS_PER_LAYER = 21, NSTEPS = 1 + DEPTH * STEPS_PER_LAYER;

__global__ void __launch_bounds__(NTHR, 2) fwd_megakernel(Args args) {
    extern __shared__ __attribute__((aligned(16))) unsigned char lds_raw[];
    cg::grid_group grid = cg::this_grid();
    const Args* ap = (const Args*)__builtin_amdgcn_kernarg_segment_ptr();
    volatile LAS unsigned* bst = (volatile LAS unsigned*)((LAS unsigned char*)lds_raw + 131072 + 64);
    if (threadIdx.x < 8) bst[threadIdx.x] = 0u;
    __syncthreads();
    for (int step = 0; step < NSTEPS; ++step) {
        asm volatile("" : "+s"(ap));
        const Args& args_ = *ap;
        Frame F;
        F.lds = (LAS unsigned char*)lds_raw;
        { int t_ = threadIdx.x; asm volatile("" : "+v"(t_)); F.tid = t_; }
        F.lane = F.tid & 63; F.wave = __builtin_amdgcn_readfirstlane(F.tid >> 6);
        { int b_ = blockIdx.x, g_ = gridDim.x; asm volatile("" : "+s"(b_), "+s"(g_)); F.bx = b_; F.G = g_; }
        F.vcu = (F.G % 8 == 0) ? (F.bx % 8) * (F.G / 8) + F.bx / 8 : F.bx;
        const bool local_ok = __builtin_amdgcn_readfirstlane(bst[4]) != 0u;
        if (local_ok) { F.xid = __builtin_amdgcn_readfirstlane(bst[2]); F.xr = __builtin_amdgcn_readfirstlane(bst[3]); F.nx = __builtin_amdgcn_readfirstlane(bst[0]); }
        else { F.xid = F.bx % 8; F.xr = F.bx / 8; F.nx = (F.G - F.xid + 7) / 8; }
        unsigned char* ws = uni(args_.ws);
        float* out = uni(args_.out);
        bool chip_wide = false;
        if (step == 0) {
            if (F.bx == 0) for (int i = F.tid; i < XCD_BAR_WORDS + 1024; i += NTHR) ((unsigned*)(ws + WS_BAR))[i] = 0u;
            p0_prologue(F, args_, ws);
        } else {
            const int sidx = step - 1, l = sidx / STEPS_PER_LAYER, ps = sidx % STEPS_PER_LAYER;
            int kind, hf = 0;
            if (ps < 4) kind = ps; else if (ps < 18) { hf = (ps - 4) / 7; kind = 4 + (ps - 4) % 7; } else kind = 11 + (ps - 18);
            chip_wide = false;
            const float* modl = (const float*)(ws + WS_MOD) + (size_t)l * 32 * NMODC;
            const bf16* W = (const bf16*)(ws + WS_WT) + (size_t)l * LW;
#define U_ ((bf16*)(ws + WS_U))
#define HID_ ((bf16*)(ws + WS_HID))
            const size_t hlo = (size_t)4096 * F.xid, fro = hlo + (size_t)4096 * hf;
            unsigned char* arena = ws + WS_X + (size_t)F.xid * ARENA;
            bf16* Gh = (bf16*)(arena + AR_G) - hlo * 2048; bf16* ZGh = (bf16*)(arena + AR_ZG) - hlo * 768; bf16* ZMh = (bf16*)(arena + AR_ZM) - hlo * 768;
            bf16* QRh = (bf16*)(arena + AR_QRAW) - hlo * 768; bf16* KVh = (bf16*)(arena + AR_KVRAW) - hlo * 1024;
            const int pmF = 32 * F.xid, pmH = 32 * F.xid + 16 * hf;
            if (kind == 0 || kind == 3 || kind == 11) {
                const bool fromx = (kind == 0 && l == 0);
                const void* hin = fromx ? (const void*)uni(args_.in[0]) : (const void*)(ws + WS_H);
                const float* gain = (kind == 0 ? uni(args_.in[4]) : kind == 3 ? uni(args_.in[7]) : uni(args_.in[20])) + l * DM;
                const int mi = (kind == 0) ? 0 : (kind == 3) ? 3 : 6;
                norm_phase(F, hin, fromx ? 0 : 1, gain, modl + mi * DM, modl + (mi + 1) * DM, U_);
            } else if (kind == 1 || kind == 12) {
                pg8::EpiB<0> E{HID_, FF, nullptr, nullptr, nullptr, nullptr, 0};
                run_gemm(F, U_, DM, W + (kind == 1 ? (size_t)0 : (size_t)14974976), pmF, 32, 2 * FF, DM, E);
            } else if (kind == 2 || kind == 10 || kind == 13) {
                if (kind == 10) {
                    bf16* hh = (bf16*)(ws + WS_H);
                    pg8::EpiRes E{hh, hh, modl + 5 * DM, 1.0f, 0, 1, 1};
                    run_gemm(F, (const bf16*)(ws + WS_MG) - fro * 1024, 1024, W + 13926400, pmH, 16, DM, DM, E);
                } else {
                    const bool fromx = (kind == 2 && l == 0), last = (kind == 13 && l == DEPTH - 1);
                    const void* hin = fromx ? (const void*)uni(args_.in[0]) : (const void*)(ws + WS_H);
                    void* hout = last ? (void*)out : (void*)(ws + WS_H);
                    pg8::EpiRes E{hin, hout, modl + (kind == 2 ? 2 : 8) * DM, 0.5f, 0, fromx ? 0 : 1, last ? 0 : 1};
                    run_gemm(F, HID_, FF, W + (kind == 2 ? (size_t)5767168 : (size_t)20742144), pmF, 32, DM, FF, E, 1);
                }
            } else if (kind == 4) {
                pg8::EpiB<1> E{Gh - fro * 2048, 2048, ZGh - fro * 768, ZMh - fro * 768, nullptr, nullptr, 0};
                run_gemm(F, U_, DM, W + 8650752, pmH, 16, 3584, DM, E);
            } else if (kind == 5) {
                pp1_phase(F, ws, ZGh, ZMh, uni(args_.in[15]) + l * 64, uni(args_.in[16]) + l * 64);
            } else if (kind == 6) {
                for (int w = 0; w < 2; ++w) {
                    pg8::EpiB<2> E{(w == 0 ? QRh - fro * 768 : KVh - fro * 1024), w == 0 ? 768 : 1024, nullptr, nullptr, nullptr, (const float*)(ws + (w == 0 ? WS_RSQ : WS_RSKV)) - fro, 0};
                    run_gemm(F, ZMh - fro * 768 + (w == 0 ? 0 : 384), 768, W + (w == 0 ? (size_t)12320768 : (size_t)12615680), pmH, 16, w == 0 ? 768 : 1024, w == 0 ? 384 : 256, E);
                }
            } else if (kind == 7) {
                pp2_phase(F, ws, QRh, KVh, ZMh, uni(args_.in[13]) + l * 96, uni(args_.in[14]) + l * 96);
            } else if (kind == 8) {
                attn_phase(F, ws);
            } else if (kind == 9) {
                for (int w = 0; w < 2; ++w) {
                    pg8::EpiB<3> E{(bf16*)(ws + WS_MG) - fro * 1024, 1024, nullptr, nullptr, Gh - fro * 2048, nullptr, w};
                    run_gemm(F, (const bf16*)(ws + (w == 0 ? WS_OM : WS_OG)) - fro * 512, 512, W + (w == 0 ? (size_t)12877824 : (size_t)13402112), pmH, 16, DM, 512, E);
                }
            }
        }
        unsigned* barw = (unsigned*)(ws + WS_BAR);
        if (step == 0) {
            grid.sync();
            if (threadIdx.x == 0) { const unsigned x = xb_xcc_id(); bst[2] = x; bst[3] = xb_add(&barw[XB_XCNT(x)], 1u); }
            __syncthreads();
            XcdBarrier bar; bar.bar = barw; bar.x = xb_xcc_id(); bar.st = bst;
            xcd_barrier(bar);
            if (threadIdx.x == 0) {
                bool ok = true;
                for (unsigned j = 0; j < 16; ++j) { const unsigned c = xb_ld(&barw[XB_XCNT(j)]); ok = ok && ((j < 8) ? (c > 0u) : (c == 0u)); }
                bst[4] = (ok && xb_ld(&barw[XB_TMO]) == 0u) ? 1u : 0u;
            }
            __syncthreads();
        } else if (step + 1 < NSTEPS) {
            if (local_ok && !chip_wide) xcd_local_barrier(barw, (unsigned)F.xid, (unsigned)F.nx);
            else { XcdBarrier bar; bar.bar = barw; bar.x = xb_xcc_id(); bar.st = bst; xcd_barrier(bar); }
        }
    }
}

extern "C" void kernel_launch(void* const* d_in, const int* in_sizes, int n_in, void* d_out, int out_size, void* d_ws, size_t ws_size, hipStream_t stream) {
    static int grid = 0;
    if (grid == 0) {
        if (n_in != 23 || out_size != TOK * DM || ws_size < WS_END) { fprintf(stderr, "kernel_launch: unexpected shapes (n_in %d, out %d, ws %zu < %zu)\n", n_in, out_size, ws_size, (size_t)WS_END); grid = -1; return; }
        int dev = 0, cus = 0, per_cu = 0;
        hipGetDevice(&dev);
        hipDeviceGetAttribute(&cus, hipDeviceAttributeMultiprocessorCount, dev);
        hipFuncSetAttribute((const void*)fwd_megakernel, hipFuncAttributeMaxDynamicSharedMemorySize, LDS_BYTES);
        hipOccupancyMaxActiveBlocksPerMultiprocessor(&per_cu, (const void*)fwd_megakernel, NTHR, LDS_BYTES);
        if (per_cu < 1) per_cu = 1;
        grid = cus * per_cu;
        (void)hipGetLastError();
    }
    if (grid < 0) return;
    Args a{};
    for (int i = 0; i < 23; ++i) a.in[i] = (const float*)d_in[i];
    a.out = (float*)d_out; a.ws = (unsigned char*)d_ws;
    void* kargs[] = {&a};
    hipError_t e = hipLaunchCooperativeKernel((const void*)fwd_megakernel, dim3(grid), dim3(NTHR), kargs, LDS_BYTES, stream);
    if (e != hipSuccess) fprintf(stderr, "cooperative launch failed: %s (grid %d)\n", hipGetErrorString(e), grid);
}
```

```cpp
#include <hip/hip_runtime.h>
#include <hip/hip_cooperative_groups.h>
#include <cstdio>
#include <cstdint>
namespace cg = cooperative_groups;

namespace pg8 {
#define PG8_LAS __attribute__((address_space(3)))
#define PG8_GAS __attribute__((address_space(1)))
typedef unsigned short bf16_t;
typedef short bf16x8 __attribute__((ext_vector_type(8)));
typedef float f32x4 __attribute__((ext_vector_type(4)));
typedef unsigned u32x4 __attribute__((ext_vector_type(4)));
constexpr int BM = 256, BK = 64, HALF = 128, HTB = HALF * BK * 2  , STAGE_BYTES = 8 * HTB, NXCD = 8, WGM = 8;

__host__ __device__ __forceinline__ int lds_byte(int r, int c) { const int st = (r >> 4) * 2 + (c >> 5), rr = r & 15, cc = c & 31, ob = rr * 64 + cc * 2; return st * 1024 + (ob ^ (((ob >> 9) & 1) << 5)); }
__host__ __device__ __forceinline__ void stage_rc(int b, int& R, int& C) { const int st = b / 1024, sb = b % 1024, swz = sb ^ (((sb >> 9) & 1) << 5); R = (st >> 1) * 16 + swz / 64; C = (st & 1) * 32 + (swz % 64) / 2; }
__host__ __device__ __forceinline__ int perm32(int rho) { const int n = rho >> 4, i = rho & 15; return 8 * (i >> 2) + 4 * n + (i & 3); }

struct Unit { int pm, pn; };
struct Gemm { const bf16_t* A; const bf16_t* Bt; int M, N, K, lda; };

struct StaticOrder {
    int nM, nN, nwg, G, c, rev;
    __host__ __device__ void init(int M, int N, int G_, int c_, int rev_ = 0) { nM = M / BM; nN = N / BM; nwg = nM * nN; G = G_; c = c_; rev = rev_; }
    __host__ __device__ bool next(int i, Unit& u) const {
        const long L = (long)i * G + c; if (L >= nwg) return false;
        int wgid = rev ? (nwg - 1 - (int)L) : (int)L; { const int q = nwg / NXCD, r = nwg % NXCD, xcd = wgid % NXCD, off = wgid / NXCD; wgid = (xcd < r ? xcd * (q + 1) : r * (q + 1) + (xcd - r) * q) + off; }
        const int nig = WGM * nN, gid = wgid / nig, fm = gid * WGM, gsz = (nM - fm) < WGM ? (nM - fm) : WGM;
        u.pm = fm + ((wgid % nig) % gsz); u.pn = (wgid % nig) / gsz; return true;
    }
    __device__ __forceinline__ void a_ready(const Unit&) const {}
    __device__ __forceinline__ void done(const Unit&) const {}
};

struct XcdOrder {
    int nN, q, r, nx, rev, pm0;
    __device__ void init(int pm0_, int LP, int N, int r_, int nx_, int rev_) { nN = N / BM; q = LP * nN; pm0 = pm0_; r = r_; nx = nx_; rev = rev_; }
    __device__ bool next(int i, Unit& u) const {
        int off = i * nx + r; if (off >= q) return false;
        if (rev) off = q - 1 - off;
        const int nig = WGM * nN, gid = off / nig, rem = off % nig;
        u.pn = rem / WGM; u.pm = pm0 + gid * WGM + rem % WGM; return true;
    }
    __device__ __forceinline__ void a_ready(const Unit&) const {}
    __device__ __forceinline__ void done(const Unit&) const {}
};

typedef float f32x2_ __attribute__((ext_vector_type(2))); typedef __bf16 bf16x2_ __attribute__((ext_vector_type(2)));
__device__ __forceinline__ unsigned cvt_pk_bf16(float lo, float hi) { const f32x2_ v = {lo, hi}; const bf16x2_ b = __builtin_convertvector(v, bf16x2_); return __builtin_bit_cast(unsigned, b); }
__device__ __forceinline__ float bf_lo(unsigned w) { return __uint_as_float(w << 16); }
__device__ __forceinline__ float bf_hi(unsigned w) { return __uint_as_float(w & 0xffff0000u); }
__device__ __forceinline__ float sigmoidf_(float x) { return __builtin_amdgcn_rcpf(1.0f + __builtin_amdgcn_exp2f(x * -1.4426950408889634f)); }

template <int MODE> struct EpiB {
    static constexpr bool PERM = true, AFTER_DRAIN = false;
    bf16_t* O; int ldc; bf16_t* O2; bf16_t* O3; const bf16_t* Gt; const float* rs; int add;
    __device__ __forceinline__ void operator()(const f32x4 (&acc)[2][2][4][2], const Unit& u, int wr, int wc, int fr, int fq) const {
        const int row0 = u.pm * BM + wr * 64 + fr;
        if constexpr (MODE == 0) {
            const int col0 = u.pn * HALF + wc * 32 + 8 * fq;
#pragma unroll
            for (int ai = 0; ai < 2; ++ai)
#pragma unroll
                for (int m = 0; m < 4; ++m) {
                    bf16_t* rowp = O + (size_t)(row0 + ai * HALF + m * 16) * ldc + col0;
                    const f32x4 a0 = acc[ai][0][m][0], a1 = acc[ai][0][m][1], b0 = acc[ai][1][m][0], b1 = acc[ai][1][m][1];
                    const float av[8] = {a0[0], a0[1], a0[2], a0[3], a1[0], a1[1], a1[2], a1[3]}, bv[8] = {b0[0], b0[1], b0[2], b0[3], b1[0], b1[1], b1[2], b1[3]};
                    float e[8], o[8];
#pragma unroll
                    for (int j = 0; j < 8; ++j) e[j] = __builtin_amdgcn_exp2f(-av[j]);
#pragma unroll
                    for (int j = 0; j < 8; ++j) e[j] = 1.0f + e[j];
#pragma unroll
                    for (int j = 0; j < 8; ++j) e[j] = __builtin_amdgcn_rcpf(e[j]);
#pragma unroll
                    for (int j = 0; j < 8; ++j) o[j] = (av[j] * bv[j]) * e[j];
                    u32x4 w; w.x = cvt_pk_bf16(o[0], o[1]); w.y = cvt_pk_bf16(o[2], o[3]); w.z = cvt_pk_bf16(o[4], o[5]); w.w = cvt_pk_bf16(o[6], o[7]);
                    *(PG8_GAS u32x4*)rowp = w;
                }
        } else {
            bf16_t* base = O; int ld = ldc; int colt = u.pn * BM;
            if constexpr (MODE == 1) { if (u.pn >= 11) { base = O3; ld = 768; colt = (u.pn - 11) * BM; } else if (u.pn >= 8) { base = O2; ld = 768; colt = (u.pn - 8) * BM; } }
            const int col0 = colt + wc * 32 + 8 * fq;
#pragma unroll
            for (int ai = 0; ai < 2; ++ai) {
                float rsc[4]; u32x4 gg[4][2], qq[4][2];
#pragma unroll
                for (int m = 0; m < 4; ++m) {
                    const int row = row0 + ai * HALF + m * 16;
                    rsc[m] = 1.f; if constexpr (MODE == 2) rsc[m] = *(const PG8_GAS float*)(rs + row);
#pragma unroll
                    for (int bj = 0; bj < 2; ++bj) {
                        if constexpr (MODE == 3) {
                            gg[m][bj] = *(const PG8_GAS u32x4*)(Gt + (size_t)row * 2048 + (add ? 1024 : 0) + col0 + bj * HALF);
                            if (add) qq[m][bj] = *(const PG8_GAS u32x4*)(base + (size_t)row * ld + col0 + bj * HALF);
                        }
                    }
                }
                asm volatile("" ::: "memory");
#pragma unroll
                for (int m = 0; m < 4; ++m) {
                    const int row = row0 + ai * HALF + m * 16;
#pragma unroll
                    for (int bj = 0; bj < 2; ++bj) {
                        bf16_t* p = base + (size_t)row * ld + col0 + bj * HALF;
                        f32x4 v0 = acc[ai][bj][m][0], v1 = acc[ai][bj][m][1];
                        if constexpr (MODE == 2) { v0 = v0 * rsc[m]; v1 = v1 * rsc[m]; }
                        if constexpr (MODE == 3) {
                            const u32x4 g = gg[m][bj];
                            float e[8] = {bf_lo(g.x), bf_hi(g.x), bf_lo(g.y), bf_hi(g.y), bf_lo(g.z), bf_hi(g.z), bf_lo(g.w), bf_hi(g.w)};
#pragma unroll
                            for (int j = 0; j < 8; ++j) e[j] = __builtin_amdgcn_exp2f(-e[j]);
#pragma unroll
                            for (int j = 0; j < 8; ++j) e[j] = 1.0f + e[j];
#pragma unroll
                            for (int j = 0; j < 8; ++j) e[j] = __builtin_amdgcn_rcpf(e[j]);
                            v0[0] *= e[0]; v0[1] *= e[1]; v0[2] *= e[2]; v0[3] *= e[3]; v1[0] *= e[4]; v1[1] *= e[5]; v1[2] *= e[6]; v1[3] *= e[7];
                            if (add) {
                                const u32x4 q = qq[m][bj];
                                v0[0] += bf_lo(q.x); v0[1] += bf_hi(q.x); v0[2] += bf_lo(q.y); v0[3] += bf_hi(q.y);
                                v1[0] += bf_lo(q.z); v1[1] += bf_hi(q.z); v1[2] += bf_lo(q.w); v1[3] += bf_hi(q.w);
                            }
                        }
                        u32x4 w; w.x = cvt_pk_bf16(v0[0], v0[1]); w.y = cvt_pk_bf16(v0[2], v0[3]); w.z = cvt_pk_bf16(v1[0], v1[1]); w.w = cvt_pk_bf16(v1[2], v1[3]);
                        *(PG8_GAS u32x4*)p = w;
                    }
                }
                asm volatile("" ::: "memory");
            }
        }
    }
};
struct EpiRes {
    static constexpr bool PERM = false, AFTER_DRAIN = false;
    const void* base; void* out; const float* gate; float coef; int row_off; int in_bf, out_bf;
    __device__ __forceinline__ void operator()(const f32x4 (&acc)[2][2][4][2], const Unit& u, int wr, int wc, int fr, int fq) const {
        typedef unsigned u32x2 __attribute__((ext_vector_type(2)));
        const int b = (u.pm * BM + row_off) >> 11;
        const int col0 = u.pn * BM + wc * 32 + 4 * fq;
        f32x4 gv[2][2];
#pragma unroll
        for (int bj = 0; bj < 2; ++bj)
#pragma unroll
            for (int n = 0; n < 2; ++n) gv[bj][n] = *(const PG8_GAS f32x4*)(gate + (size_t)b * 9216 + col0 + bj * HALF + n * 16) * coef;
#pragma unroll
        for (int ai = 0; ai < 2; ++ai)
#pragma unroll
            for (int mh = 0; mh < 2; ++mh) {
                u32x4 raw[2][2][2];
#pragma unroll
                for (int mm = 0; mm < 2; ++mm) {
                    const size_t off = (size_t)(u.pm * BM + ai * HALF + wr * 64 + (2 * mh + mm) * 16 + fr) * 1024 + col0;
#pragma unroll
                    for (int bj = 0; bj < 2; ++bj)
#pragma unroll
                        for (int n = 0; n < 2; ++n) {
                            const size_t o = off + bj * HALF + n * 16;
                            if (in_bf) { const u32x2 w = *(const PG8_GAS u32x2*)((const bf16_t*)base + o); raw[mm][bj][n].x = w.x; raw[mm][bj][n].y = w.y; }
                            else raw[mm][bj][n] = *(const PG8_GAS u32x4*)((const float*)base + o);
                        }
                }
                asm volatile("" ::: "memory");
#pragma unroll
                for (int mm = 0; mm < 2; ++mm) {
                    const int m = 2 * mh + mm;
                    const size_t off = (size_t)(u.pm * BM + ai * HALF + wr * 64 + m * 16 + fr) * 1024 + col0;
#pragma unroll
                    for (int bj = 0; bj < 2; ++bj)
#pragma unroll
                        for (int n = 0; n < 2; ++n) {
                            const size_t o = off + bj * HALF + n * 16;
                            const u32x4 w4 = raw[mm][bj][n];
                            f32x4 bs;
                            if (in_bf) bs = (f32x4){bf_lo(w4.x), bf_hi(w4.x), bf_lo(w4.y), bf_hi(w4.y)};
                            else bs = (f32x4){__uint_as_float(w4.x), __uint_as_float(w4.y), __uint_as_float(w4.z), __uint_as_float(w4.w)};
                            const f32x4 r = bs + gv[bj][n] * acc[ai][bj][m][n];
                            if (out_bf) { u32x2 w; w.x = cvt_pk_bf16(r[0], r[1]); w.y = cvt_pk_bf16(r[2], r[3]); *(PG8_GAS u32x2*)((bf16_t*)out + o) = w; }
                            else *(PG8_GAS f32x4*)((float*)out + o) = r;
                        }
                }
                asm volatile("" ::: "memory");
            }
    }
};

template <class Epi, class Sched, bool ALIGN_EPI = false, bool SP2 = false>
__device__ __forceinline__ void gemm_phase(PG8_LAS unsigned char* lds, const Gemm g, const Sched& S, const Epi& E, const int tid) {
    const int wid = __builtin_amdgcn_readfirstlane(tid >> 6), lane = tid & 63, wr = wid >> 2, wc = wid & 3, fr = lane & 15, fq = lane >> 4;
    const int K = g.K, lda = g.lda, nt = K / BK;
    unsigned voffA[2], voffB[2];
#pragma unroll
    for (int i = 0; i < 2; ++i) { int R, C; stage_rc(tid * 16 + i * 8192, R, C); const int Rb = Epi::PERM ? ((R & ~31) + perm32(R & 31)) : R;
        voffA[i] = (unsigned)(R * lda + C) * 2u; voffB[i] = (unsigned)(Rb * K + C) * 2u; }
    const size_t kstep = (size_t)(BK * 2);
    const size_t hstepA = (size_t)HALF * lda * 2, hstepB = (size_t)HALF * K * 2;
    const size_t tstepA = 2 * hstepA, tstepB = 2 * hstepB;
    const unsigned ldsw = (unsigned)wid * 1024u;
    const int aoff = lds_byte(wr * 64 + fr, fq * 8), boff = lds_byte(wc * 32 + fr, fq * 8);
#define PG8_SA(b, h) (((b) * 2 + (h)) * HTB)
#define PG8_SB(b, h) ((4 + (b) * 2 + (h)) * HTB)
#define PG8_STAGE(bufoff, gbase, voff) do { _Pragma("unroll") for (int _i = 0; _i < 2; ++_i) \
        __builtin_amdgcn_global_load_lds((const unsigned*)((const char*)(gbase) + (voff)[_i]), (PG8_LAS unsigned*)(lds + (bufoff) + ldsw + _i * 8192), 16, 0, 0); } while (0)
#define PG8_LDA(dst, b, h) do { _Pragma("unroll") for (int m = 0; m < 4; ++m) _Pragma("unroll") for (int k = 0; k < 2; ++k) dst[m][k] = *(const PG8_LAS bf16x8*)(lds + PG8_SA(b, h) + aoff + m * 2048 + k * 1024); } while (0)
#define PG8_LDB(dst, b, h) do { _Pragma("unroll") for (int n = 0; n < 2; ++n) _Pragma("unroll") for (int k = 0; k < 2; ++k) dst[n][k] = *(const PG8_LAS bf16x8*)(lds + PG8_SB(b, h) + boff + n * 2048 + k * 1024); } while (0)
#define PG8_MMA(ai, bj, At, Bt) do { __builtin_amdgcn_s_setprio(1); _Pragma("unroll") for (int m = 0; m < 4; ++m) _Pragma("unroll") for (int n = 0; n < 2; ++n) _Pragma("unroll") for (int k = 0; k < 2; ++k) \
        acc[ai][bj][m][n] = __builtin_amdgcn_mfma_f32_16x16x32_bf16(Bt[n][k], At[m][k], acc[ai][bj][m][n], 0, 0, 0); __builtin_amdgcn_s_setprio(0); } while (0)
#define PG8_WAIT_V(n) asm volatile("s_waitcnt vmcnt(" #n ")" ::: "memory")
#define PG8_WAIT_L(n) asm volatile("s_waitcnt lgkmcnt(" #n ")" ::: "memory")
#define PG8_BAR __builtin_amdgcn_s_barrier()
#define PG8_SCHED __builtin_amdgcn_sched_barrier(0)
    Unit cur, nxt; int ui = 0;
    if (!S.next(0, cur)) return;
    f32x4 acc[2][2][4][2];
#pragma unroll
    for (int a = 0; a < 2; ++a)
#pragma unroll
        for (int b = 0; b < 2; ++b)
#pragma unroll
            for (int m = 0; m < 4; ++m)
#pragma unroll
                for (int n = 0; n < 2; ++n) acc[a][b][m][n] = (f32x4){0.f, 0.f, 0.f, 0.f};
    bf16x8 At[4][2], B0[2][2], B1[2][2];
    const char* cA = (const char*)g.A + (size_t)cur.pm * tstepA; const char* cB = (const char*)g.Bt + (size_t)cur.pn * tstepB;
    S.a_ready(cur);
    if constexpr (SP2) {
        PG8_STAGE(PG8_SB(0, 0), cB, voffB); PG8_STAGE(PG8_SB(0, 1), cB + hstepB, voffB); PG8_STAGE(PG8_SA(0, 0), cA, voffA); PG8_STAGE(PG8_SA(0, 1), cA + hstepA, voffA);
        if (wr == 1) PG8_BAR;
        PG8_WAIT_V(2); PG8_BAR;
        PG8_STAGE(PG8_SB(1, 0), cB + kstep, voffB); PG8_STAGE(PG8_SA(1, 0), cA + kstep, voffA); PG8_STAGE(PG8_SB(1, 1), cB + hstepB + kstep, voffB);
        PG8_WAIT_V(6); PG8_BAR;
    } else {
        PG8_STAGE(PG8_SB(0, 0), cB, voffB); PG8_STAGE(PG8_SA(0, 0), cA, voffA); PG8_STAGE(PG8_SB(0, 1), cB + hstepB, voffB); PG8_STAGE(PG8_SA(0, 1), cA + hstepA, voffA);
        if (wr == 1) PG8_BAR;
        PG8_WAIT_V(4); PG8_BAR;
        PG8_STAGE(PG8_SB(1, 0), cB + kstep, voffB); PG8_STAGE(PG8_SA(1, 0), cA + kstep, voffA); PG8_STAGE(PG8_SB(1, 1), cB + hstepB + kstep, voffB);
        PG8_WAIT_V(6); PG8_BAR;
    }
    for (;;) {
        const bool has_next = S.next(ui + 1, nxt);
        const char* nA = has_next ? (const char*)g.A + (size_t)nxt.pm * tstepA : cA; const char* nB = has_next ? (const char*)g.Bt + (size_t)nxt.pn * tstepB : cB;
        for (int t = 0; t < nt; t += 2) {
            const bool last = (t == nt - 2);
            const char* a1 = cA + (size_t)(t + 1) * kstep;
            const char* a2 = last ? nA : cA + (size_t)(t + 2) * kstep; const char* b2 = last ? nB : cB + (size_t)(t + 2) * kstep;
            const char* a3 = a2 + kstep; const char* b3 = b2 + kstep;
            if (last && has_next) S.a_ready(nxt);
            if constexpr (SP2) {
            PG8_LDB(B0, 0, 0); PG8_LDB(B1, 0, 1); PG8_SCHED; PG8_LDA(At, 0, 0); PG8_STAGE(PG8_SA(1, 1), a1 + hstepA, voffA);
            PG8_WAIT_V(8); PG8_WAIT_L(0); PG8_BAR; PG8_MMA(0, 0, At, B0); PG8_MMA(0, 1, At, B1); PG8_BAR; PG8_SCHED;
            PG8_LDA(At, 0, 1); PG8_STAGE(PG8_SB(0, 0), b2, voffB); PG8_STAGE(PG8_SB(0, 1), b2 + hstepB, voffB); PG8_STAGE(PG8_SA(0, 0), a2, voffA);
            PG8_WAIT_V(8); PG8_WAIT_L(0); PG8_BAR; PG8_MMA(1, 0, At, B0); PG8_MMA(1, 1, At, B1); PG8_BAR; PG8_SCHED;
            PG8_LDB(B0, 1, 0); PG8_LDB(B1, 1, 1); PG8_SCHED; PG8_LDA(At, 1, 0); PG8_STAGE(PG8_SA(0, 1), a2 + hstepA, voffA);
            PG8_WAIT_V(8); PG8_WAIT_L(0); PG8_BAR; PG8_MMA(0, 0, At, B0); PG8_MMA(0, 1, At, B1); PG8_BAR; PG8_SCHED;
            PG8_LDA(At, 1, 1); PG8_STAGE(PG8_SB(1, 0), b3, voffB); PG8_STAGE(PG8_SB(1, 1), b3 + hstepB, voffB); PG8_STAGE(PG8_SA(1, 0), a3, voffA);
            PG8_WAIT_V(8); PG8_WAIT_L(0); PG8_BAR; PG8_MMA(1, 0, At, B0); PG8_MMA(1, 1, At, B1); PG8_BAR; PG8_SCHED;
            } else {
            PG8_LDB(B0, 0, 0); PG8_SCHED; PG8_LDA(At, 0, 0); PG8_STAGE(PG8_SA(1, 1), a1 + hstepA, voffA);
            PG8_WAIT_L(8); PG8_BAR; PG8_WAIT_L(0); PG8_MMA(0, 0, At, B0); PG8_BAR; PG8_SCHED;
            PG8_LDB(B1, 0, 1); PG8_STAGE(PG8_SB(0, 0), b2, voffB);
            PG8_BAR; PG8_WAIT_L(0); PG8_MMA(0, 1, At, B1); PG8_BAR;
            PG8_LDA(At, 0, 1); PG8_STAGE(PG8_SA(0, 0), a2, voffA);
            PG8_BAR; PG8_WAIT_L(0); PG8_MMA(1, 0, At, B0); PG8_BAR; PG8_SCHED;
            PG8_STAGE(PG8_SB(0, 1), b2 + hstepB, voffB);
            PG8_WAIT_V(6); PG8_BAR; PG8_MMA(1, 1, At, B1); PG8_BAR;
            PG8_LDB(B0, 1, 0); PG8_SCHED; PG8_LDA(At, 1, 0); PG8_STAGE(PG8_SA(0, 1), a2 + hstepA, voffA);
            PG8_WAIT_L(8); PG8_BAR; PG8_WAIT_L(0); PG8_MMA(0, 0, At, B0); PG8_BAR; PG8_SCHED;
            PG8_LDB(B1, 1, 1); PG8_STAGE(PG8_SB(1, 0), b3, voffB);
            PG8_BAR; PG8_WAIT_L(0); PG8_MMA(0, 1, At, B1); PG8_BAR;
            PG8_LDA(At, 1, 1); PG8_STAGE(PG8_SA(1, 0), a3, voffA);
            PG8_BAR; PG8_WAIT_L(0); PG8_MMA(1, 0, At, B0); PG8_BAR; PG8_SCHED;
            PG8_STAGE(PG8_SB(1, 1), b3 + hstepB, voffB);
            PG8_WAIT_V(6); PG8_BAR; PG8_MMA(1, 1, At, B1); PG8_BAR;
            }
        }
        if constexpr (ALIGN_EPI) { if (wr == 0) PG8_BAR; }
        if constexpr (!Epi::AFTER_DRAIN) { E(acc, cur, wr, wc, fr, fq); S.done(cur); }
        if (!has_next) break;
#pragma unroll
        for (int a = 0; a < 2; ++a)
#pragma unroll
            for (int b = 0; b < 2; ++b)
#pragma unroll
                for (int m = 0; m < 4; ++m)
#pragma unroll
                    for (int n = 0; n < 2; ++n) acc[a][b][m][n] = (f32x4){0.f, 0.f, 0.f, 0.f};
        cur = nxt; cA = nA; cB = nB; ++ui;
        if constexpr (ALIGN_EPI) { if (wr == 1) PG8_BAR; }
    }
    PG8_WAIT_V(0);
    if constexpr (!ALIGN_EPI) { if (wr == 0) PG8_BAR; }
    PG8_BAR;
    if constexpr (Epi::AFTER_DRAIN) { E.fused(acc, cur, wr, wc, fr, fq, lds, wid, lane); S.done(cur); }
#undef PG8_SA
#undef PG8_SB
#undef PG8_STAGE
#undef PG8_LDA
#undef PG8_LDB
#undef PG8_MMA
#undef PG8_WAIT_V
#undef PG8_WAIT_L
#undef PG8_BAR
#undef PG8_SCHED
}
}

#define LAS __attribute__((address_space(3)))
#define GASP __attribute__((address_space(1)))
typedef unsigned short bf16;
typedef unsigned v4u __attribute__((ext_vector_type(4)));
typedef unsigned v2u __attribute__((ext_vector_type(2)));
typedef float f32x2 __attribute__((ext_vector_type(2)));
typedef float f32x4 __attribute__((ext_vector_type(4)));
typedef float f32x16 __attribute__((ext_vector_type(16)));
typedef short bf16x8 __attribute__((ext_vector_type(8)));

constexpr int NWAVES = 8, NTHR = 512;
constexpr int BATCH = 32, SEQ = 2048, DM = 1024, DEPTH = 2, TOK = BATCH * SEQ, FF = 2816, NMODC = 9216;
constexpr int TH = TOK / 2;
constexpr float EPS = 1e-6f;
constexpr float QS_G = 0.125f * 1.4426950408889634f;
constexpr float QS_M = 0.10206207261596575f * 1.4426950408889634f;
constexpr int LDS_BYTES = 147456;

constexpr size_t MiB = 1u << 20;
constexpr size_t WS_MOD = 0, WS_CS = 3 * MiB, WS_RSQ = WS_CS + 262144, WS_RSKV = WS_RSQ + 131072;
constexpr size_t WS_BAR = WS_RSKV + 131072;
constexpr size_t WS_WT = 4 * MiB, WS_U = 100 * MiB, WS_X = 228 * MiB;
constexpr size_t WS_HID = WS_X;
constexpr size_t ARENA = (size_t)8192 * FF * 2, AR_G = 0, AR_ZG = 16 * MiB, AR_ZM = 22 * MiB, AR_QRAW = 28 * MiB, AR_KVRAW = 34 * MiB;
static_assert(AR_KVRAW + (size_t)4096 * 1024 * 2 <= ARENA && 8 * ARENA == (size_t)TOK * FF * 2, "arena map");
constexpr size_t WS_Y = 580 * MiB;
constexpr size_t WS_QG = WS_Y, WS_KG = WS_Y + 32 * MiB, WS_VTG = WS_Y + 40 * MiB, WS_QM = WS_Y + 48 * MiB, WS_KM = WS_Y + 96 * MiB, WS_VTM = WS_Y + 144 * MiB,
                 WS_OM = WS_Y + 176 * MiB, WS_OG = WS_Y + 208 * MiB, WS_MG = WS_Y + 240 * MiB, WS_H = WS_Y + 304 * MiB  , WS_END = WS_Y + 432 * MiB;
static_assert(WS_HID + (size_t)TOK * FF * 2 <= WS_Y, "ws map");
constexpr size_t LW = 23625728;
static_assert(WS_WT + 2 * LW * 2 <= WS_U, "weights fit");

struct Frame {
    LAS unsigned char* lds;
    int tid, lane, wave, vcu, G, bx;
    int xid, xr, nx;
};

__device__ __forceinline__ float wave_sum(float v) {
#pragma unroll
    for (int o = 1; o < 64; o <<= 1) v += __shfl_xor(v, o);
    return v;
}
template <class T> __device__ __forceinline__ T* uni(T* p) {
    const unsigned long long v = (unsigned long long)p;
    const unsigned lo = __builtin_amdgcn_readfirstlane((unsigned)v), hi = __builtin_amdgcn_readfirstlane((unsigned)(v >> 32));
    return (T*)(((unsigned long long)hi << 32) | lo);
}
__device__ __forceinline__ float bf2f(bf16 v) { return __uint_as_float((unsigned)v << 16); }
__device__ __forceinline__ unsigned f2bf(float f) { unsigned u = __float_as_uint(f); return (u + 0x7fffu + ((u >> 16) & 1u)) >> 16; }
__device__ __forceinline__ unsigned pk2(float lo, float hi) { return f2bf(lo) | (f2bf(hi) << 16); }

__device__ __forceinline__ void mat_info(int mat, int& K, int& Nd, int& Ns, size_t& off, int& in_idx, int& gain_idx) {
    gain_idx = -1;
    switch (mat) {
        case 0: K = 1024; Nd = 5632; Ns = 5632; off = 0; in_idx = 5; break;
        case 1: K = 2816; Nd = 1024; Ns = 1024; off = 5767168; in_idx = 6; break;
        case 2: K = 1024; Nd = 3584; Ns = 3488; off = 8650752; in_idx = 8; break;
        case 3: K = 384; Nd = 768; Ns = 768; off = 12320768; in_idx = 10; gain_idx = 9; break;
        case 4: K = 256; Nd = 1024; Ns = 1024; off = 12615680; in_idx = 12; gain_idx = 11; break;
        case 5: K = 512; Nd = 1024; Ns = 1024; off = 12877824; in_idx = 17; break;
        case 6: K = 512; Nd = 1024; Ns = 1024; off = 13402112; in_idx = 18; break;
        case 7: K = 1024; Nd = 1024; Ns = 1024; off = 13926400; in_idx = 19; break;
        case 8: K = 1024; Nd = 5632; Ns = 5632; off = 14974976; in_idx = 21; break;
        default: K = 2816; Nd = 1024; Ns = 1024; off = 20742144; in_idx = 22; break;
    }
}
__device__ __forceinline__ int mat_items(int mat) {
    switch (mat) { case 0: case 8: return 2816; case 1: case 9: return 1408; case 2: return 1792; case 3: return 144; case 4: return 128; case 5: case 6: return 256; default: return 512; }
}
constexpr int ITEMS_PER_LAYER = 2816 + 1408 + 1792 + 144 + 128 + 256 + 256 + 512 + 2816 + 1408;

__device__ __forceinline__ void cvt_item(const float* W, int K, int Ns, int src0, const float* gain, float cscale, bf16* WT, int n0, int k0, LAS float* scr, int lane) {
    float v_[32];
#pragma unroll
    for (int i = 0; i < 32; ++i) {
        const int kk = 2 * i + (lane >> 5);
        v_[i] = 0.f;
        if (src0 >= 0) v_[i] = W[(size_t)(k0 + kk) * Ns + src0 + (lane & 31)];
    }
#pragma unroll
    for (int i = 0; i < 32; ++i) {
        const int kk = 2 * i + (lane >> 5);
        float v = v_[i] * cscale;
        if (gain) v *= gain[k0 + kk];
        scr[kk * 33 + (lane & 31)] = v;
    }
    asm volatile("s_waitcnt lgkmcnt(0)" ::: "memory");
    const int c = lane & 7;
#pragma unroll
    for (int j = 0; j < 4; ++j) {
        const int n = (lane >> 3) + 8 * j; const LAS float* s = scr + (8 * c) * 33 + n;
        v4u o; o.x = pk2(s[0 * 33], s[1 * 33]); o.y = pk2(s[2 * 33], s[3 * 33]); o.z = pk2(s[4 * 33], s[5 * 33]); o.w = pk2(s[6 * 33], s[7 * 33]);
        *(v4u*)(WT + (size_t)(n0 + n) * K + k0 + 8 * c) = o;
    }
    asm volatile("s_waitcnt lgkmcnt(0)" ::: "memory");
}

struct Args { const float* in[23]; float* out; unsigned char* ws; int pad[2]; };
__device__ __forceinline__ const float* in_sel(const Args& a, int idx) {
    switch (idx) {
        case 5: return uni(a.in[5]); case 6: return uni(a.in[6]); case 8: return uni(a.in[8]); case 9: return uni(a.in[9]); case 10: return uni(a.in[10]); case 11: return uni(a.in[11]); case 12: return uni(a.in[12]);
        case 17: return uni(a.in[17]); case 18: return uni(a.in[18]); case 19: return uni(a.in[19]); case 21: return uni(a.in[21]); default: return uni(a.in[22]);
    }
}
__device__ __forceinline__ void p0_prologue(Frame& F, const Args& A, unsigned char* ws) {
    LAS float* scr = (LAS float*)(F.lds + F.wave * 16384);
    const int gw = F.vcu * NWAVES + F.wave, NGW = F.G * NWAVES;
    bf16* WT = (bf16*)(ws + WS_WT);
    for (int it = gw; it < DEPTH * ITEMS_PER_LAYER; it += NGW) {
        const int l = it / ITEMS_PER_LAYER; int r = it % ITEMS_PER_LAYER; int mat = 0;
        for (;;) { const int n = mat_items(mat); if (r < n) break; r -= n; ++mat; }
        int K, Nd, Ns, in_idx, gain_idx; size_t off; mat_info(mat, K, Nd, Ns, off, in_idx, gain_idx);
        const int nblk = Nd / 32, kb = r / nblk, nb = r % nblk, n0 = nb * 32, k0 = kb * 64;
        int src0 = n0; float cscale = 1.0f;
        if (mat == 0 || mat == 8) { const int pn = n0 >> 8, rr = n0 & 255, bj = rr >> 7, cc = rr & 127; src0 = bj * FF + 128 * pn + cc; cscale = bj == 0 ? 1.4426950408889634f : 0.6931471805599453f; }
        else if (mat == 2) { src0 = (n0 < 2048) ? 1440 + n0 : (n0 < 2816) ? 672 + (n0 - 2048) : (n0 < 3488) ? (n0 - 2816) : -1; if (n0 < 2048) cscale = 1.4426950408889634f; }
        const float* W = in_sel(A, in_idx) + (size_t)l * K * Ns;
        const float* gain = gain_idx >= 0 ? in_sel(A, gain_idx) + (size_t)l * K : nullptr;
        cvt_item(W, K, Ns, src0, gain, cscale, WT + (size_t)l * LW + off, n0, k0, scr, F.lane);
    }
    {
        f32x2* CS = (f32x2*)(ws + WS_CS);
        for (int idx = (F.vcu * NTHR + F.tid); idx < 2048 * 16; idx += F.G * NTHR) {
            const int pos = idx >> 4, i = idx & 15;
            const float inv = exp2f(-(float)i * (13.287712379549449f / 16.0f));
            const float ang = (float)pos * inv;
            const double rev = (double)ang * 0.15915494309189535;
            const float fr = (float)(rev - __builtin_rint(rev));
            CS[idx] = (f32x2){__builtin_amdgcn_cosf(fr), __builtin_amdgcn_sinf(fr)};
        }
    }
    __syncthreads();
    {
        LAS float* cs = (LAS float*)F.lds;
        const float* c = uni(A.in[1]);
        float* mod = (float*)(ws + WS_MOD);
        for (int it = F.vcu; it < DEPTH * (NMODC / 64); it += F.G) {
            for (int idx = F.tid; idx < 32 * 1024; idx += NTHR) { const int k = idx >> 5, b = idx & 31; const float v = c[b * 1024 + k]; cs[idx] = v / (1.0f + __expf(-v)); }
            __syncthreads();
            const int l = it / (NMODC / 64), jb = it % (NMODC / 64), col = jb * 64 + F.lane;
            const float* w = uni(A.in[2]) + (size_t)l * 1024 * NMODC + col;
            float acc[32];
#pragma unroll
            for (int b = 0; b < 32; ++b) acc[b] = 0.f;
            const int kbeg = F.wave * 128;
#pragma unroll 4
            for (int k = kbeg; k < kbeg + 128; ++k) {
                const float wv = w[(size_t)k * NMODC];
                const LAS f32x4* cr = (const LAS f32x4*)(cs + k * 32);
#pragma unroll
                for (int b4 = 0; b4 < 8; ++b4) { const f32x4 cv = cr[b4]; acc[4 * b4] += cv[0] * wv; acc[4 * b4 + 1] += cv[1] * wv; acc[4 * b4 + 2] += cv[2] * wv; acc[4 * b4 + 3] += cv[3] * wv; }
            }
            __syncthreads();
            LAS float* red = (LAS float*)F.lds;
#pragma unroll
            for (int b = 0; b < 32; ++b) red[(F.wave * 32 + b) * 64 + F.lane] = acc[b];
            __syncthreads();
#pragma unroll
            for (int q = 0; q < 4; ++q) {
                const int idx = F.tid + NTHR * q, b = idx >> 6, cc = idx & 63;
                float sum = uni(A.in[3])[(size_t)l * NMODC + jb * 64 + cc];
#pragma unroll
                for (int wv = 0; wv < 8; ++wv) sum += red[(wv * 32 + b) * 64 + cc];
                mod[((size_t)l * 32 + b) * NMODC + jb * 64 + cc] = sum;
            }
            __syncthreads();
        }
    }
}

template <int CTRL> __device__ __forceinline__ float dppf(float v) { return __builtin_bit_cast(float, __builtin_amdgcn_update_dpp(0, __builtin_bit_cast(int, v), CTRL, 0xF, 0xF, true)); }
__device__ __forceinline__ float row8_sum(float v) { v += dppf<0xB1>(v); v += dppf<0x4E>(v); v += dppf<0x141>(v); return v; }
__device__ __forceinline__ float row16_sum(float v) { v = row8_sum(v); v += dppf<0x140>(v); return v; }
__device__ __forceinline__ f32x4 ld4bf(const bf16* p) { const v2u w = *(const GASP v2u*)p; return (f32x4){__uint_as_float(w.x << 16), __uint_as_float(w.x & 0xffff0000u), __uint_as_float(w.y << 16), __uint_as_float(w.y & 0xffff0000u)}; }
__device__ __forceinline__ v2u pk4(f32x4 v) { v2u w; w.x = pk2(v[0], v[1]); w.y = pk2(v[2], v[3]); return w; }
__device__ __forceinline__ float dot4(f32x4 x) { return (x[0] * x[0] + x[1] * x[1]) + (x[2] * x[2] + x[3] * x[3]); }
__device__ __forceinline__ f32x4 rope4(f32x4 y, f32x4 cA, f32x4 cB, bool hi) {
    f32x4 p; p[0] = __shfl_xor(y[0], 4); p[1] = __shfl_xor(y[1], 4); p[2] = __shfl_xor(y[2], 4); p[3] = __shfl_xor(y[3], 4);
    if (!hi) p = -p;
    return (f32x4){y[0] * cA[0] + p[0] * cA[1], y[1] * cA[2] + p[1] * cA[3], y[2] * cB[0] + p[2] * cB[1], y[3] * cB[2] + p[3] * cB[3]};
}

__device__ __forceinline__ void norm_phase(Frame& F, const void* h, int h_bf, const float* gain, const float* sh, const float* sc, bf16* U) {
    const int lw = F.xr * NWAVES + F.wave, NLW = F.nx * NWAVES;
    for (int lb = lw; lb < 256; lb += NLW) {
        const int blk = 256 * F.xid + lb;
        const int m0 = blk * 32, b = m0 >> 11;
        f32x4 A[4], B[4];
#pragma unroll
        for (int j = 0; j < 4; ++j) {
            const int col = 256 * j + 4 * F.lane;
            A[j] = *(const GASP f32x4*)(gain + col) * (*(const GASP f32x4*)(sc + (size_t)b * NMODC + col) + 1.0f);
            B[j] = *(const GASP f32x4*)(sh + (size_t)b * NMODC + col);
        }
#pragma unroll 4
        for (int r = 0; r < 32; ++r) {
            const int m = m0 + r;
            f32x4 v[4]; float s = 0.f;
            if (h_bf) {
                const bf16* xr = (const bf16*)h + (size_t)m * DM + 4 * F.lane;
#pragma unroll
                for (int j = 0; j < 4; ++j) { v[j] = ld4bf(xr + 256 * j); s += dot4(v[j]); }
            } else {
                const f32x4* xr = (const f32x4*)((const float*)h + (size_t)m * DM) + F.lane;
#pragma unroll
                for (int j = 0; j < 4; ++j) { v[j] = *(const GASP f32x4*)(xr + 64 * j); s += dot4(v[j]); }
            }
            s = row16_sum(s); s += __shfl_xor(s, 16); s += __shfl_xor(s, 32);
            const float rstd = rsqrtf(s * (1.f / DM) + EPS);
            v2u* o8 = (v2u*)(U + (size_t)m * DM) + F.lane;
#pragma unroll
            for (int j = 0; j < 4; ++j) *(GASP v2u*)(o8 + 64 * j) = pk4(v[j] * rstd * A[j] + B[j]);
        }
    }
}

__device__ __forceinline__ void pp1_phase(Frame& F, unsigned char* ws, const bf16* ZG, const bf16* ZM, const float* gqn, const float* gkn) {
    float* RSQ = (float*)(ws + WS_RSQ); float* RSKV = (float*)(ws + WS_RSKV);
    bf16* QG = (bf16*)(ws + WS_QG); bf16* KG = (bf16*)(ws + WS_KG); bf16* VTG = (bf16*)(ws + WS_VTG);
    const float* CS = (const float*)(ws + WS_CS);
    const int lane = F.lane, a = lane & 15;
    const f32x4 gq4 = *(const GASP f32x4*)(gqn + 4 * a), gk4 = *(const GASP f32x4*)(gkn + 4 * a);
    const bool hi = (a & 4) != 0;
    LAS bf16* stage = (LAS bf16*)F.lds;
    for (int lc = F.xr; lc < 64; lc += F.nx) {
        const int ch = 64 * F.xid + lc;
        const int lr0 = ch * 64, bl = lr0 >> 11, s0 = lr0 & 2047;
#pragma unroll 2
        for (int i = 0; i < 8; ++i) {
            const int tk = F.wave * 8 + i, lr = lr0 + tk, s = s0 + tk;
            const bf16* zg = ZG + (size_t)lr * 768; const bf16* zm = ZM + (size_t)lr * 768;
            float ss = dot4(ld4bf(zm + 4 * lane)); if (lane < 32) ss += dot4(ld4bf(zm + 256 + 4 * lane));
            ss = wave_sum(ss); if (lane == 0) RSQ[lr] = rsqrtf(ss * (1.f / 384.f) + EPS);
            ss = wave_sum(dot4(ld4bf(zm + 384 + 4 * lane))); if (lane == 0) RSKV[lr] = rsqrtf(ss * (1.f / 256.f) + EPS);
            const int pos = (a < 8) ? (s >> 6) : (s & 63);
            const f32x4 cA = *(const GASP f32x4*)(CS + (pos * 16 + 4 * (a & 3)) * 2), cB = *(const GASP f32x4*)(CS + (pos * 16 + 4 * (a & 3)) * 2 + 4);
#pragma unroll
            for (int j = 0; j < 3; ++j) {
                const v2u raw = *(const GASP v2u*)(zg + 256 * j + 4 * lane);
                const f32x4 x = (f32x4){__uint_as_float(raw.x << 16), __uint_as_float(raw.x & 0xffff0000u), __uint_as_float(raw.y << 16), __uint_as_float(raw.y & 0xffff0000u)};
                const float q = row16_sum(dot4(x));
                const float r = rsqrtf(q * (1.f / 64.f) + EPS);
                const f32x4 o = rope4(x * r * (j < 2 ? gq4 : gk4), cA, cB, hi);
                if (j < 2) *(GASP v2u*)(QG + (size_t)lr * 512 + 256 * j + 4 * lane) = pk4(o * QS_G);
                else if (lane < 32) *(GASP v2u*)(KG + (size_t)lr * 128 + 4 * lane) = pk4(o);
                else *(LAS v2u*)(stage + tk * 132 + 4 * (lane - 32)) = raw;
            }
        }
        __syncthreads();
#pragma unroll
        for (int jj = 0; jj < 2; ++jj) {
            const int it = F.tid + 512 * jj, hd = it >> 3, cc = it & 7;
            unsigned e[8];
#pragma unroll
            for (int j = 0; j < 8; ++j) e[j] = stage[(8 * cc + j) * 132 + hd];
            v4u o; o.x = e[0] | (e[1] << 16); o.y = e[2] | (e[3] << 16); o.z = e[4] | (e[5] << 16); o.w = e[6] | (e[7] << 16);
            *(GASP v4u*)(VTG + ((size_t)(bl * 128 + hd)) * 2048 + s0 + 8 * cc) = o;
        }
        __syncthreads();
    }
}

__device__ __forceinline__ void pp2_phase(Frame& F, unsigned char* ws, const bf16* QRAW, const bf16* KVRAW, const bf16* ZM, const float* gqn, const float* gkn) {
    bf16* QM = (bf16*)(ws + WS_QM); bf16* KM = (bf16*)(ws + WS_KM); bf16* VTM = (bf16*)(ws + WS_VTM);
    const float* CS = (const float*)(ws + WS_CS);
    const int lane = F.lane, a = lane & 15, hh = lane >> 4, a8 = lane & 7, h8 = lane >> 3;
    const f32x4 g0q = *(const GASP f32x4*)(gqn + 4 * a), g1q = *(const GASP f32x4*)(gqn + 64 + 4 * a8), g0k = *(const GASP f32x4*)(gkn + 4 * a), g1k = *(const GASP f32x4*)(gkn + 64 + 4 * a8);
    const bool hi = (a8 & 4) != 0;
    LAS bf16* stage = (LAS bf16*)F.lds;
    for (int lc = F.xr; lc < 64; lc += F.nx) {
        const int ch = 64 * F.xid + lc;
        const int lr0 = ch * 64, bl = lr0 >> 11, s0 = lr0 & 2047;
#pragma unroll 2
        for (int i = 0; i < 8; ++i) {
            const int tk = F.wave * 8 + i, lr = lr0 + tk, s = s0 + tk;
            const bf16* qr = QRAW + (size_t)lr * 768; const bf16* kvr = KVRAW + (size_t)lr * 1024; const bf16* zm = ZM + (size_t)lr * 768;
            const f32x4 cA = *(const GASP f32x4*)(CS + (s * 16 + 4 * (a8 & 3)) * 2), cB = *(const GASP f32x4*)(CS + (s * 16 + 4 * (a8 & 3)) * 2 + 4);
            {
                const f32x4 xr = ld4bf(qr + 96 * h8 + 64 + 4 * a8);
                const float ssr = row8_sum(dot4(xr));
                float rp[2];
#pragma unroll
                for (int p = 0; p < 2; ++p) {
                    const f32x4 xn = ld4bf(qr + 96 * (4 * p + hh) + 4 * a);
                    const float ssn = row16_sum(dot4(xn));
                    const float ssrh = __shfl(ssr, 32 * p + 8 * hh);
                    const float r = rsqrtf((ssn + ssrh) * (1.f / 96.f) + EPS); rp[p] = r;
                    *(GASP v2u*)(QM + (size_t)lr * 768 + 96 * (4 * p + hh) + 4 * a) = pk4(xn * g0q * (r * QS_M));
                }
                const float r0 = __shfl(rp[0], 16 * (h8 & 3)), r1 = __shfl(rp[1], 16 * (h8 & 3));
                const float rr = (h8 < 4) ? r0 : r1;
                const f32x4 o = rope4(xr * g1q * rr, cA, cB, hi);
                *(GASP v2u*)(QM + (size_t)lr * 768 + 96 * h8 + 64 + 4 * a8) = pk4(o * QS_M);
            }
            {
                const f32x4 kr = ld4bf(zm + 640 + 4 * a8);
                const float sspe = row8_sum(dot4(kr));
                float rp[2];
#pragma unroll
                for (int p = 0; p < 2; ++p) {
                    const f32x4 xn = ld4bf(kvr + 128 * (4 * p + hh) + 4 * a);
                    const float ssn = row16_sum(dot4(xn));
                    const float r = rsqrtf((ssn + sspe) * (1.f / 96.f) + EPS); rp[p] = r;
                    *(GASP v2u*)(KM + (size_t)lr * 768 + 96 * (4 * p + hh) + 4 * a) = pk4(xn * g0k * r);
                    *(LAS v2u*)(stage + tk * 516 + 64 * (4 * p + hh) + 4 * a) = *(const GASP v2u*)(kvr + 128 * (4 * p + hh) + 64 + 4 * a);
                }
                const float r0 = __shfl(rp[0], 16 * (h8 & 3)), r1 = __shfl(rp[1], 16 * (h8 & 3));
                const float rr = (h8 < 4) ? r0 : r1;
                const f32x4 o = rope4(kr * g1k * rr, cA, cB, hi);
                *(GASP v2u*)(KM + (size_t)lr * 768 + 96 * h8 + 64 + 4 * a8) = pk4(o);
            }
        }
        __syncthreads();
#pragma unroll 2
        for (int jj = 0; jj < 8; ++jj) {
            const int it = F.tid + 512 * jj, hd = it >> 3, cc = it & 7;
            unsigned e[8];
#pragma unroll
            for (int j = 0; j < 8; ++j) e[j] = stage[(8 * cc + j) * 516 + hd];
            v4u o; o.x = e[0] | (e[1] << 16); o.y = e[2] | (e[3] << 16); o.z = e[4] | (e[5] << 16); o.w = e[6] | (e[7] << 16);
            *(GASP v4u*)(VTM + ((size_t)(bl * 512 + hd)) * 2048 + s0 + 8 * cc) = o;
        }
        __syncthreads();
    }
}

typedef __bf16 bf16x2_t __attribute__((ext_vector_type(2)));
__device__ __forceinline__ unsigned cvtpk(float lo, float hi) { const f32x2 v = {lo, hi}; const bf16x2_t b = __builtin_convertvector(v, bf16x2_t); return __builtin_bit_cast(unsigned, b); }
#define ATT_BAR() asm volatile("s_waitcnt lgkmcnt(0)\n\ts_barrier" ::: "memory")
template <int DQ>
__device__ __forceinline__ void attn_unit(LAS unsigned char* lds, const bf16* Qp, int ldq, const bf16* Kp, int ldk, const bf16* Vtp, bf16* Op, int tid, int lane, int wave) {
    constexpr int KP = DQ * 2 + 16, VP = 144, KBUF = 64 * KP, VBUF = 64 * VP, ND = DQ / 16, KCH = DQ / 8, NKC = 64 * KCH, NT = SEQ / 64;
    constexpr bool K2 = NKC > 512;
    constexpr float THR = 8.0f;
    const int q = lane & 31, hi = lane >> 5;
    bf16x8 qf[ND];
#pragma unroll
    for (int d0 = 0; d0 < ND; ++d0) qf[d0] = *(const GASP bf16x8*)(Qp + (size_t)(wave * 32 + q) * ldq + d0 * 16 + hi * 8);
    const int kr0 = tid / KCH, kc0 = tid % KCH, kr1 = (tid + 512) / KCH, kc1 = (tid + 512) % KCH;
    const bool k1v = K2 && (tid + 512 < NKC);
    const unsigned kg0 = (unsigned)(kr0 * ldk + kc0 * 8) * 2u;
    const unsigned kg1 = (unsigned)((k1v ? kr1 : 0) * ldk + (k1v ? kc1 : 0) * 8) * 2u;
    const int vd = tid >> 3, vc = tid & 7;
    const unsigned vg = (unsigned)(vd * 2048 + vc * 8) * 2u;
    const int ks0 = kr0 * KP + kc0 * 16, ks1 = kr1 * KP + kc1 * 16, vs = 2 * KBUF + vd * VP + vc * 16;
    const int pq = (q & 0x13) | ((q & 4) << 1) | ((q & 8) >> 1);
    const int ka = pq * KP + hi * 16, va = 2 * KBUF + q * VP + hi * 16;
#define LOADK(R, tile) do { const char* kt_ = (const char*)(Kp + (size_t)(tile) * 64 * ldk); R##_k0 = *(const GASP v4u*)(kt_ + kg0); if (K2) { if (k1v) R##_k1 = *(const GASP v4u*)(kt_ + kg1); } } while (0)
#define LOADV(R, tile) do { R##_v = *(const GASP v4u*)((const char*)(Vtp + (tile) * 64) + vg); } while (0)
#define STOREK(R, buf) do { *(LAS v4u*)(lds + (buf) * KBUF + ks0) = R##_k0; if (K2) { if (k1v) *(LAS v4u*)(lds + (buf) * KBUF + ks1) = R##_k1; } } while (0)
#define STOREV(R, buf) do { *(LAS v4u*)(lds + (buf) * VBUF + vs) = R##_v; } while (0)
#define QKT(S0, S1, buf, C0, C1) do { const LAS unsigned char* Kb_ = lds + (buf) * KBUF + ka; \
        _Pragma("unroll") for (int d0 = 0; d0 < ND; ++d0) { \
            const bf16x8 a0_ = *(const LAS bf16x8*)(Kb_ + d0 * 32), a1_ = *(const LAS bf16x8*)(Kb_ + 32 * KP + d0 * 32); \
            S0 = __builtin_amdgcn_mfma_f32_32x32x16_bf16(a0_, qf[d0], d0 == 0 ? C0 : S0, 0, 0, 0); \
            S1 = __builtin_amdgcn_mfma_f32_32x32x16_bf16(a1_, qf[d0], d0 == 0 ? C1 : S1, 0, 0, 0); } } while (0)
#define PVT(buf) do { const LAS unsigned char* Vb_ = lds + (buf) * VBUF + va; \
        _Pragma("unroll") for (int jj = 0; jj < 4; ++jj) { \
            const bf16x8 v0_ = *(const LAS bf16x8*)(Vb_ + jj * 32), v1_ = *(const LAS bf16x8*)(Vb_ + 32 * VP + jj * 32); \
            const bf16x8 pf_ = __builtin_bit_cast(bf16x8, pw[jj]); \
            o0 = __builtin_amdgcn_mfma_f32_32x32x16_bf16(v0_, pf_, o0, 0, 0, 0); \
            o1 = __builtin_amdgcn_mfma_f32_32x32x16_bf16(v1_, pf_, o1, 0, 0, 0); } } while (0)
    v4u a_k0, a_k1 = (v4u){0u, 0u, 0u, 0u}, a_v, b_k0, b_k1 = (v4u){0u, 0u, 0u, 0u}, b_v;
    LOADK(a, 0); LOADK(b, 1); LOADV(a, 0);
    STOREK(a, 0); STOREK(b, 1); STOREV(a, 1);
    LOADK(a, 2); LOADK(b, 3); LOADV(b, 1);
    ATT_BAR();
    f32x16 zero16, sc0, sc1, sn0, sn1, o0, o1, negm;
#pragma unroll
    for (int r = 0; r < 16; ++r) { zero16[r] = 0.f; o0[r] = 0.f; o1[r] = 0.f; }
    QKT(sc0, sc1, 0, zero16, zero16);
    float l_run = 0.f;
    {
        float mx = fmaxf(sc0[0], sc1[0]);
#pragma unroll
        for (int r = 1; r < 16; ++r) mx = fmaxf(mx, fmaxf(sc0[r], sc1[r]));
        mx = fmaxf(mx, __shfl_xor(mx, 32));
#pragma unroll
        for (int r = 0; r < 16; ++r) { sc0[r] -= mx; sc1[r] -= mx; negm[r] = -mx; }
    }
    v4u pw[4];
#pragma unroll
    for (int jj = 0; jj < 4; ++jj) pw[jj] = (v4u){0u, 0u, 0u, 0u};
#define FRAG_ADDR(i, BQ, BP) (((i) < 2 * ND) ? (lds + (BQ) * KBUF + ka + ((i) & 1) * 32 * KP + ((i) >> 1) * 32) \
                                             : (lds + (BP) * VBUF + va + (((i) - 2 * ND) & 1) * 32 * VP + (((i) - 2 * ND) >> 1) * 32))
#define SLICE(k, SC0, SC1, PW) do { \
        float e0_, e1_; \
        if ((k) < 8) { e0_ = __builtin_amdgcn_exp2f(SC0[2 * (k)]); e1_ = __builtin_amdgcn_exp2f(SC0[2 * (k) + 1]); } \
        else { e0_ = __builtin_amdgcn_exp2f(SC1[2 * (k) - 16]); e1_ = __builtin_amdgcn_exp2f(SC1[2 * (k) - 15]); } \
        lsA_ += e0_; lsB_ += e1_; \
        unsigned w_ = cvtpk(e0_, e1_); asm volatile("" : "+v"(w_), "+v"(lsA_), "+v"(lsB_)); PW[(k) >> 2][(k) & 3] = w_; \
    } while (0)
#define STAGE(t, R, BQ, BP, BS, PR, PW, SC0, SC1, SN0, SN1) do { \
        constexpr int NQ_ = 2 * ND, NM_ = NQ_ + 8; \
        constexpr int FD_ = 3, FR_ = FD_ + 1, SL0_ = 3;     \
        bf16x8 fr_[FR_]; \
        _Pragma("unroll") for (int i = 0; i < FD_; ++i) fr_[i] = *(const LAS bf16x8*)FRAG_ADDR(i, BQ, BP); \
        float lsA_ = 0.f, lsB_ = 0.f, mx_ = -INFINITY; \
        _Pragma("unroll") for (int k = 0; k < SL0_; ++k) { SLICE(k, SC0, SC1, PW); } \
        __builtin_amdgcn_sched_barrier(0); \
        _Pragma("unroll") for (int i = 0; i < NM_; ++i) { \
            if (i + FD_ < NM_) fr_[(i + FD_) % FR_] = *(const LAS bf16x8*)FRAG_ADDR(i + FD_, BQ, BP); \
            if (i < NQ_) { \
                const int d0_ = i >> 1; \
                if ((i & 1) == 0) SN0 = __builtin_amdgcn_mfma_f32_32x32x16_bf16(fr_[i % FR_], qf[d0_], d0_ == 0 ? negm : SN0, 0, 0, 0); \
                else              SN1 = __builtin_amdgcn_mfma_f32_32x32x16_bf16(fr_[i % FR_], qf[d0_], d0_ == 0 ? negm : SN1, 0, 0, 0); \
            } else { \
                const int j_ = i - NQ_; const bf16x8 pf_ = __builtin_bit_cast(bf16x8, PR[j_ >> 1]); \
                if ((j_ & 1) == 0) o0 = __builtin_amdgcn_mfma_f32_32x32x16_bf16(fr_[i % FR_], pf_, o0, 0, 0, 0); \
                else               o1 = __builtin_amdgcn_mfma_f32_32x32x16_bf16(fr_[i % FR_], pf_, o1, 0, 0, 0); \
            } \
            if (i + SL0_ < 16) { SLICE(i + SL0_, SC0, SC1, PW); }                  \
            if (i >= NM_ - 6) { \
                _Pragma("unroll") for (int r = 3 * (i - (NM_ - 6)); r < 3 * (i - (NM_ - 6)) + 3; ++r) if (r < 16) mx_ = fmaxf(fmaxf(mx_, SN0[r]), SN1[r]); \
                asm volatile("" : "+v"(mx_)); \
            } \
            if (i == 13) { STOREK(R, BS); }                    \
            if (i == 14) { STOREV(R, BS); } \
            if (i == 15) { const int tk_ = ((t) + 4 < NT) ? (t) + 4 : NT - 1, tv_ = ((t) + 2 < NT) ? (t) + 2 : NT - 1; LOADK(R, tk_); LOADV(R, tv_); } \
            __builtin_amdgcn_sched_barrier(0); \
        } \
        l_run = l_run * al_pend + (lsA_ + lsB_); \
        ATT_BAR(); \
        if (pend) { _Pragma("unroll") for (int r = 0; r < 16; ++r) { o0[r] *= al_pend; o1[r] *= al_pend; } } \
        pend = false; al_pend = 1.0f; \
        if (__any(mx_ > THR)) { \
            const float rm_ = fmaxf(mx_, __shfl_xor(mx_, 32)); \
            const float dl_ = fmaxf(rm_, 0.f); \
            al_pend = __builtin_amdgcn_exp2f(-dl_); pend = true; \
            _Pragma("unroll") for (int r = 0; r < 16; ++r) { SN0[r] -= dl_; SN1[r] -= dl_; negm[r] -= dl_; } \
        } \
    } while (0)
    float al_pend = 1.0f; bool pend = false;
    v4u pw2[4];
    for (int t = 0; t < NT; t += 2) {
        STAGE(t, a, 1, 1, 0, pw, pw2, sc0, sc1, sn0, sn1);
        STAGE(t + 1, b, 0, 0, 1, pw2, pw, sn0, sn1, sc0, sc1);
    }
#undef FRAG_ADDR
#undef SLICE
    PVT(1);
    l_run += __shfl_xor(l_run, 32);
    const float inv = __builtin_amdgcn_rcpf(l_run);
    bf16* orow = Op + (size_t)(wave * 32 + q) * 512 + 4 * hi;
#pragma unroll
    for (int a = 0; a < 4; ++a) {
        v2u w0, w1;
        w0.x = cvtpk(o0[4 * a] * inv, o0[4 * a + 1] * inv); w0.y = cvtpk(o0[4 * a + 2] * inv, o0[4 * a + 3] * inv);
        w1.x = cvtpk(o1[4 * a] * inv, o1[4 * a + 1] * inv); w1.y = cvtpk(o1[4 * a + 2] * inv, o1[4 * a + 3] * inv);
        *(GASP v2u*)(orow + 8 * a) = w0; *(GASP v2u*)(orow + 32 + 8 * a) = w1;
    }
    ATT_BAR();
#undef LOADK
#undef LOADV
#undef STOREK
#undef STOREV
#undef QKT
#undef PVT
#undef STAGE
}

__device__ __forceinline__ void attn_phase(Frame& F, unsigned char* ws) {
    const bf16* QM = (const bf16*)(ws + WS_QM); const bf16* KM = (const bf16*)(ws + WS_KM); const bf16* VTM = (const bf16*)(ws + WS_VTM); bf16* OM = (bf16*)(ws + WS_OM);
    const bf16* QG = (const bf16*)(ws + WS_QG); const bf16* KG = (const bf16*)(ws + WS_KG); const bf16* VTG = (const bf16*)(ws + WS_VTG); bf16* OG = (bf16*)(ws + WS_OG);
    constexpr int NU = 16 * 8 * 8;
    for (int lu = F.xr; lu < 256; lu += F.nx) {
        const int U = (lu < 128) ? (2 * F.xid) * 64 + lu : NU + (2 * F.xid) * 64 + (lu - 128);
        int tid_ = F.tid; asm volatile("" : "+v"(tid_));
        const int lane_ = tid_ & 63, wave_ = __builtin_amdgcn_readfirstlane(tid_ >> 6);
        if (U < NU) {
            const int qb = U & 7, h = (U >> 3) & 7, bl = U >> 6;
            const size_t r0 = (size_t)bl * 2048;
            attn_unit<96>(F.lds, QM + (r0 + qb * 256) * 768 + h * 96, 768, KM + r0 * 768 + h * 96, 768, VTM + (size_t)((bl * 8 + h) * 64) * 2048, OM + (r0 + qb * 256) * 512 + h * 64, tid_, lane_, wave_);
        } else {
            const int u = U - NU, qb = u & 7, hq = (u >> 3) & 7, bl = u >> 6, kvh = hq >> 2;
            const size_t r0 = (size_t)bl * 2048;
            attn_unit<64>(F.lds, QG + (r0 + qb * 256) * 512 + hq * 64, 512, KG + r0 * 128 + kvh * 64, 128, VTG + (size_t)((bl * 2 + kvh) * 64) * 2048, OG + (r0 + qb * 256) * 512 + hq * 64, tid_, lane_, wave_);
        }
    }
}

typedef __attribute__((address_space(1))) unsigned gu32;
#define XB_TMO      128
#define XB_XCNT(j)  (256  + 64 * (j))
#define XB_XSUB(j)  (1280 + 64 * (j))
#define XB_XGEN(j)  (2304 + 64 * (j))
#define XB_TOP      3328
#define XB_TOPGEN   3392
#define XCD_BAR_WORDS 3456
#define XB_SPIN_CAP (1u << 18)

__device__ __forceinline__ unsigned xb_ld(unsigned* p)              { return __hip_atomic_load(p, __ATOMIC_RELAXED, __HIP_MEMORY_SCOPE_AGENT); }
__device__ __forceinline__ unsigned xb_add(unsigned* p, unsigned v) { return __hip_atomic_fetch_add(p, v, __ATOMIC_RELAXED, __HIP_MEMORY_SCOPE_AGENT); }
__device__ __forceinline__ unsigned xb_xcc_id() { return (unsigned)__builtin_amdgcn_s_getreg((3 << 11) | 20) & 0xFu; }
#define XB_SPIN(cond, bar) do { unsigned _sp = 0; while (cond) { __builtin_amdgcn_s_sleep(1); \
    if ((++_sp & 255u) == 0u) { if (xb_ld(&(bar)[XB_TMO])) break; if (_sp > XB_SPIN_CAP) { atomicAdd(&(bar)[XB_TMO], 1u); break; } } } } while (0)

struct XcdBarrier {
    unsigned* bar; unsigned x;
    volatile LAS unsigned* st;
};

__device__ __forceinline__ XcdBarrier xcd_barrier_post(unsigned* bar, volatile LAS unsigned* st) {
    XcdBarrier b; b.bar = bar; b.x = xb_xcc_id(); b.st = st;
    if (threadIdx.x == 0) (void)xb_add(&bar[XB_XCNT(b.x)], 1u);
    return b;
}
__device__ __forceinline__ void xcd_barrier_complete(unsigned* bar, unsigned x, unsigned& nloc, unsigned& nx) {
    const unsigned G = gridDim.x * gridDim.y * gridDim.z;
    unsigned sum, cnt, mine, sp = 0u;
    for (;;) {
        sum = 0u; cnt = 0u; mine = 0u;
#pragma unroll
        for (unsigned j = 0; j < 16; ++j) { const unsigned c = xb_ld(&bar[XB_XCNT(j)]); sum += c; cnt += (c > 0u) ? 1u : 0u; mine = (j == x) ? c : mine; }
        if (sum == G) break;
        __builtin_amdgcn_s_sleep(1);
        if ((++sp & 255u) == 0u) { if (xb_ld(&bar[XB_TMO])) break; if (sp > XB_SPIN_CAP) { atomicAdd(&bar[XB_TMO], 1u); break; } }
    }
    nloc = mine > 0u ? mine : 1u; nx = cnt > 0u ? cnt : 1u;
}

__device__ __forceinline__ void xcd_barrier(const XcdBarrier& b) {
    asm volatile("s_waitcnt vmcnt(0)" ::: "memory");
    __syncthreads();
    if (threadIdx.x == 0) {
        unsigned* bar = b.bar;
        __builtin_amdgcn_s_waitcnt(0);
        unsigned nloc = b.st[0], nx = b.st[1];
        if (nloc == 0u) { xcd_barrier_complete(bar, b.x, nloc, nx); b.st[0] = nloc; b.st[1] = nx; }
        const unsigned old = xb_add(&bar[XB_XSUB(b.x)], 1u);
        const unsigned gen = old / nloc;
        if (old + 1u == (gen + 1u) * nloc) {
            __builtin_amdgcn_fence(__ATOMIC_RELEASE, "agent");
            asm volatile("s_waitcnt vmcnt(0)" ::: "memory");
            const unsigned og = xb_add(&bar[XB_TOP], 1u);
            const unsigned tg = og / nx;
            if (og + 1u == (tg + 1u) * nx) xb_add(&bar[XB_TOPGEN], 1u);
            else XB_SPIN(xb_ld(&bar[XB_TOPGEN]) == tg, bar);
            __builtin_amdgcn_fence(__ATOMIC_ACQUIRE, "agent");
            xb_add(&bar[XB_XGEN(b.x)], 1u);
            asm volatile("s_waitcnt vmcnt(0)" ::: "memory");
        } else {
            XB_SPIN(xb_ld(&bar[XB_XGEN(b.x)]) == gen, bar);
            __builtin_amdgcn_fence(__ATOMIC_ACQUIRE, "agent");
            asm volatile("s_waitcnt vmcnt(0)" ::: "memory");
        }
    }
    __syncthreads();
}

#define LB_SUB(j) (XCD_BAR_WORDS + 64 * (j))
#define LB_GEN(j) (XCD_BAR_WORDS + 512 + 64 * (j))
__device__ __forceinline__ void xcd_local_barrier(unsigned* bar, unsigned x, unsigned nx) {
    asm volatile("s_waitcnt vmcnt(0)" ::: "memory");
    __syncthreads();
    if (threadIdx.x == 0) {
        const unsigned old = xb_add(&bar[LB_SUB(x)], 1u);
        const unsigned gen = old / nx;
        if (old + 1u == (gen + 1u) * nx) xb_add(&bar[LB_GEN(x)], 1u);
        else XB_SPIN(xb_ld(&bar[LB_GEN(x)]) == gen, bar);
        __builtin_amdgcn_fence(__ATOMIC_ACQUIRE, "agent");
        asm volatile("s_waitcnt vmcnt(0)" ::: "memory");
    }
    __syncthreads();
}

template <class Epi>
__device__ __forceinline__ void run_gemm(Frame& F, const bf16* A, int lda, const bf16* Bt, int pm0, int LP, int N, int K, const Epi& E, int rev = 0) {
    pg8::Gemm g{A, Bt, TOK, N, K, lda}; pg8::XcdOrder S; S.init(pm0, LP, N, F.xr, F.nx, rev);
    pg8::gemm_phase<Epi, pg8::XcdOrder, true, true>(F.lds, g, S, E, F.tid);
}

constexpr int STEPS_PER_LAYER = 21, NSTEPS = 1 + DEPTH * STEPS_PER_LAYER;

__global__ void __launch_bounds__(NTHR, 2) fwd_megakernel(Args args) {
    extern __shared__ __attribute__((aligned(16))) unsigned char lds_raw[];
    cg::grid_group grid = cg::this_grid();
    const Args* ap = (const Args*)__builtin_amdgcn_kernarg_segment_ptr();
    volatile LAS unsigned* bst = (volatile LAS unsigned*)((LAS unsigned char*)lds_raw + 131072 + 64);
    if (threadIdx.x < 8) bst[threadIdx.x] = 0u;
    __syncthreads();
    for (int step = 0; step < NSTEPS; ++step) {
        asm volatile("" : "+s"(ap));
        const Args& args_ = *ap;
        Frame F;
        F.lds = (LAS unsigned char*)lds_raw;
        { int t_ = threadIdx.x; asm volatile("" : "+v"(t_)); F.tid = t_; }
        F.lane = F.tid & 63; F.wave = __builtin_amdgcn_readfirstlane(F.tid >> 6);
        { int b_ = blockIdx.x, g_ = gridDim.x; asm volatile("" : "+s"(b_), "+s"(g_)); F.bx = b_; F.G = g_; }
        F.vcu = (F.G % 8 == 0) ? (F.bx % 8) * (F.G / 8) + F.bx / 8 : F.bx;
        const bool local_ok = __builtin_amdgcn_readfirstlane(bst[4]) != 0u;
        if (local_ok) { F.xid = __builtin_amdgcn_readfirstlane(bst[2]); F.xr = __builtin_amdgcn_readfirstlane(bst[3]); F.nx = __builtin_amdgcn_readfirstlane(bst[0]); }
        else { F.xid = F.bx % 8; F.xr = F.bx / 8; F.nx = (F.G - F.xid + 7) / 8; }
        unsigned char* ws = uni(args_.ws);
        float* out = uni(args_.out);
        bool chip_wide = false;
        if (step == 0) {
            if (F.bx == 0) for (int i = F.tid; i < XCD_BAR_WORDS + 1024; i += NTHR) ((unsigned*)(ws + WS_BAR))[i] = 0u;
            p0_prologue(F, args_, ws);
        } else {
            const int sidx = step - 1, l = sidx / STEPS_PER_LAYER, ps = sidx % STEPS_PER_LAYER;
            int kind, hf = 0;
            if (ps < 4) kind = ps; else if (ps < 18) { hf = (ps - 4) / 7; kind = 4 + (ps - 4) % 7; } else kind = 11 + (ps - 18);
            chip_wide = false;
            const float* modl = (const float*)(ws + WS_MOD) + (size_t)l * 32 * NMODC;
            const bf16* W = (const bf16*)(ws + WS_WT) + (size_t)l * LW;
#define U_ ((bf16*)(ws + WS_U))
#define HID_ ((bf16*)(ws + WS_HID))
            const size_t hlo = (size_t)4096 * F.xid, fro = hlo + (size_t)4096 * hf;
            unsigned char* arena = ws + WS_X + (size_t)F.xid * ARENA;
            bf16* Gh = (bf16*)(arena + AR_G) - hlo * 2048; bf16* ZGh = (bf16*)(arena + AR_ZG) - hlo * 768; bf16* ZMh = (bf16*)(arena + AR_ZM) - hlo * 768;
            bf16* QRh = (bf16*)(arena + AR_QRAW) - hlo * 768; bf16* KVh = (bf16*)(arena + AR_KVRAW) - hlo * 1024;
            const int pmF = 32 * F.xid, pmH = 32 * F.xid + 16 * hf;
            if (kind == 0 || kind == 3 || kind == 11) {
                const bool fromx = (kind == 0 && l == 0);
                const void* hin = fromx ? (const void*)uni(args_.in[0]) : (const void*)(ws + WS_H);
                const float* gain = (kind == 0 ? uni(args_.in[4]) : kind == 3 ? uni(args_.in[7]) : uni(args_.in[20])) + l * DM;
                const int mi = (kind == 0) ? 0 : (kind == 3) ? 3 : 6;
                norm_phase(F, hin, fromx ? 0 : 1, gain, modl + mi * DM, modl + (mi + 1) * DM, U_);
            } else if (kind == 1 || kind == 12) {
                pg8::EpiB<0> E{HID_, FF, nullptr, nullptr, nullptr, nullptr, 0};
                run_gemm(F, U_, DM, W + (kind == 1 ? (size_t)0 : (size_t)14974976), pmF, 32, 2 * FF, DM, E);
            } else if (kind == 2 || kind == 10 || kind == 13) {
                if (kind == 10) {
                    bf16* hh = (bf16*)(ws + WS_H);
                    pg8::EpiRes E{hh, hh, modl + 5 * DM, 1.0f, 0, 1, 1};
                    run_gemm(F, (const bf16*)(ws + WS_MG) - fro * 1024, 1024, W + 13926400, pmH, 16, DM, DM, E);
                } else {
                    const bool fromx = (kind == 2 && l == 0), last = (kind == 13 && l == DEPTH - 1);
                    const void* hin = fromx ? (const void*)uni(args_.in[0]) : (const void*)(ws + WS_H);
                    void* hout = last ? (void*)out : (void*)(ws + WS_H);
                    pg8::EpiRes E{hin, hout, modl + (kind == 2 ? 2 : 8) * DM, 0.5f, 0, fromx ? 0 : 1, last ? 0 : 1};
                    run_gemm(F, HID_, FF, W + (kind == 2 ? (size_t)5767168 : (size_t)20742144), pmF, 32, DM, FF, E, 1);
                }
            } else if (kind == 4) {
                pg8::EpiB<1> E{Gh - fro * 2048, 2048, ZGh - fro * 768, ZMh - fro * 768, nullptr, nullptr, 0};
                run_gemm(F, U_, DM, W + 8650752, pmH, 16, 3584, DM, E);
            } else if (kind == 5) {
                pp1_phase(F, ws, ZGh, ZMh, uni(args_.in[15]) + l * 64, uni(args_.in[16]) + l * 64);
            } else if (kind == 6) {
                for (int w = 0; w < 2; ++w) {
                    pg8::EpiB<2> E{(w == 0 ? QRh - fro * 768 : KVh - fro * 1024), w == 0 ? 768 : 1024, nullptr, nullptr, nullptr, (const float*)(ws + (w == 0 ? WS_RSQ : WS_RSKV)) - fro, 0};
                    run_gemm(F, ZMh - fro * 768 + (w == 0 ? 0 : 384), 768, W + (w == 0 ? (size_t)12320768 : (size_t)12615680), pmH, 16, w == 0 ? 768 : 1024, w == 0 ? 384 : 256, E);
                }
            } else if (kind == 7) {
                pp2_phase(F, ws, QRh, KVh, ZMh, uni(args_.in[13]) + l * 96, uni(args_.in[14]) + l * 96);
            } else if (kind == 8) {
                attn_phase(F, ws);
            } else if (kind == 9) {
                for (int w = 0; w < 2; ++w) {
                    pg8::EpiB<3> E{(bf16*)(ws + WS_MG) - fro * 1024, 1024, nullptr, nullptr, Gh - fro * 2048, nullptr, w};
                    run_gemm(F, (const bf16*)(ws + (w == 0 ? WS_OM : WS_OG)) - fro * 512, 512, W + (w == 0 ? (size_t)12877824 : (size_t)13402112), pmH, 16, DM, 512, E);
                }
            }
        }
        unsigned* barw = (unsigned*)(ws + WS_BAR);
        if (step == 0) {
            grid.sync();
            if (threadIdx.x == 0) { const unsigned x = xb_xcc_id(); bst[2] = x; bst[3] = xb_add(&barw[XB_XCNT(x)], 1u); }
            __syncthreads();
            XcdBarrier bar; bar.bar = barw; bar.x = xb_xcc_id(); bar.st = bst;
            xcd_barrier(bar);
            if (threadIdx.x == 0) {
                bool ok = true;
                for (unsigned j = 0; j < 16; ++j) { const unsigned c = xb_ld(&barw[XB_XCNT(j)]); ok = ok && ((j < 8) ? (c > 0u) : (c == 0u)); }
                bst[4] = (ok && xb_ld(&barw[XB_TMO]) == 0u) ? 1u : 0u;
            }
            __syncthreads();
        } else if (step + 1 < NSTEPS) {
            if (local_ok && !chip_wide) xcd_local_barrier(barw, (unsigned)F.xid, (unsigned)F.nx);
            else { XcdBarrier bar; bar.bar = barw; bar.x = xb_xcc_id(); bar.st = bst; xcd_barrier(bar); }
        }
    }
}

extern "C" void kernel_launch(void* const* d_in, const int* in_sizes, int n_in, void* d_out, int out_size, void* d_ws, size_t ws_size, hipStream_t stream) {
    static int grid = 0;
    if (grid == 0) {
        if (n_in != 23 || out_size != TOK * DM || ws_size < WS_END) { fprintf(stderr, "kernel_launch: unexpected shapes (n_in %d, out %d, ws %zu < %zu)\n", n_in, out_size, ws_size, (size_t)WS_END); grid = -1; return; }
        int dev = 0, cus = 0, per_cu = 0;
        hipGetDevice(&dev);
        hipDeviceGetAttribute(&cus, hipDeviceAttributeMultiprocessorCount, dev);
        hipFuncSetAttribute((const void*)fwd_megakernel, hipFuncAttributeMaxDynamicSharedMemorySize, LDS_BYTES);
        hipOccupancyMaxActiveBlocksPerMultiprocessor(&per_cu, (const void*)fwd_megakernel, NTHR, LDS_BYTES);
        if (per_cu < 1) per_cu = 1;
        grid = cus * per_cu;
        (void)hipGetLastError();
    }
    if (grid < 0) return;
    Args a{};
    for (int i = 0; i < 23; ++i) a.in[i] = (const float*)d_in[i];
    a.out = (float*)d_out; a.ws = (unsigned char*)d_ws;
    void* kargs[] = {&a};
    hipError_t e = hipLaunchCooperativeKernel((const void*)fwd_megakernel, dim3(grid), dim3(NTHR), kargs, LDS_BYTES, stream);
    if (e != hipSuccess) fprintf(stderr, "cooperative launch failed: %s (grid %d)\n", hipGetErrorString(e), grid);
}
```

```cpp
#include <hip/hip_runtime.h>
#include <hip/hip_cooperative_groups.h>
#include <cstdio>
#include <cstdint>
namespace cg = cooperative_groups;

namespace pg8 {
#define PG8_LAS __attribute__((address_space(3)))
#define PG8_GAS __attribute__((address_space(1)))
typedef unsigned short bf16_t;
typedef short bf16x8 __attribute__((ext_vector_type(8)));
typedef float f32x4 __attribute__((ext_vector_type(4)));
typedef unsigned u32x4 __attribute__((ext_vector_type(4)));
constexpr int BM = 256, BK = 64, HALF = 128, HTB = HALF * BK * 2  , STAGE_BYTES = 8 * HTB, NXCD = 8, WGM = 8;

__host__ __device__ __forceinline__ int lds_byte(int r, int c) { const int st = (r >> 4) * 2 + (c >> 5), rr = r & 15, cc = c & 31, ob = rr * 64 + cc * 2; return st * 1024 + (ob ^ (((ob >> 9) & 1) << 5)); }
__host__ __device__ __forceinline__ void stage_rc(int b, int& R, int& C) { const int st = b / 1024, sb = b % 1024, swz = sb ^ (((sb >> 9) & 1) << 5); R = (st >> 1) * 16 + swz / 64; C = (st & 1) * 32 + (swz % 64) / 2; }
__host__ __device__ __forceinline__ int perm32(int rho) { const int n = rho >> 4, i = rho & 15; return 8 * (i >> 2) + 4 * n + (i & 3); }

struct Unit { int pm, pn; };
struct Gemm { const bf16_t* A; const bf16_t* Bt; int M, N, K, lda; };

struct StaticOrder {
    int nM, nN, nwg, G, c, rev;
    __host__ __device__ void init(int M, int N, int G_, int c_, int rev_ = 0) { nM = M / BM; nN = N / BM; nwg = nM * nN; G = G_; c = c_; rev = rev_; }
    __host__ __device__ bool next(int i, Unit& u) const {
        const long L = (long)i * G + c; if (L >= nwg) return false;
        int wgid = rev ? (nwg - 1 - (int)L) : (int)L; { const int q = nwg / NXCD, r = nwg % NXCD, xcd = wgid % NXCD, off = wgid / NXCD; wgid = (xcd < r ? xcd * (q + 1) : r * (q + 1) + (xcd - r) * q) + off; }
        const int nig = WGM * nN, gid = wgid / nig, fm = gid * WGM, gsz = (nM - fm) < WGM ? (nM - fm) : WGM;
        u.pm = fm + ((wgid % nig) % gsz); u.pn = (wgid % nig) / gsz; return true;
    }
    __device__ __forceinline__ void a_ready(const Unit&) const {}
    __device__ __forceinline__ void done(const Unit&) const {}
};

struct XcdOrder {
    int nN, q, r, nx, rev, pm0;
    __device__ void init(int pm0_, int LP, int N, int r_, int nx_, int rev_) { nN = N / BM; q = LP * nN; pm0 = pm0_; r = r_; nx = nx_; rev = rev_; }
    __device__ bool next(int i, Unit& u) const {
        int off = i * nx + r; if (off >= q) return false;
        if (rev) off = q - 1 - off;
        const int nig = WGM * nN, gid = off / nig, rem = off % nig;
        u.pn = rem / WGM; u.pm = pm0 + gid * WGM + rem % WGM; return true;
    }
    __device__ __forceinline__ void a_ready(const Unit&) const {}
    __device__ __forceinline__ void done(const Unit&) const {}
};

typedef float f32x2_ __attribute__((ext_vector_type(2))); typedef __bf16 bf16x2_ __attribute__((ext_vector_type(2)));
__device__ __forceinline__ unsigned cvt_pk_bf16(float lo, float hi) { const f32x2_ v = {lo, hi}; const bf16x2_ b = __builtin_convertvector(v, bf16x2_); return __builtin_bit_cast(unsigned, b); }
__device__ __forceinline__ float bf_lo(unsigned w) { return __uint_as_float(w << 16); }
__device__ __forceinline__ float bf_hi(unsigned w) { return __uint_as_float(w & 0xffff0000u); }
__device__ __forceinline__ float sigmoidf_(float x) { return __builtin_amdgcn_rcpf(1.0f + __builtin_amdgcn_exp2f(x * -1.4426950408889634f)); }

template <int MODE> struct EpiB {
    static constexpr bool PERM = true, AFTER_DRAIN = false;
    bf16_t* O; int ldc; bf16_t* O2; bf16_t* O3; const bf16_t* Gt; const float* rs; int add;
    __device__ __forceinline__ void operator()(const f32x4 (&acc)[2][2][4][2], const Unit& u, int wr, int wc, int fr, int fq) const {
        const int row0 = u.pm * BM + wr * 64 + fr;
        if constexpr (MODE == 0) {
            const int col0 = u.pn * HALF + wc * 32 + 8 * fq;
#pragma unroll
            for (int ai = 0; ai < 2; ++ai)
#pragma unroll
                for (int m = 0; m < 4; ++m) {
                    bf16_t* rowp = O + (size_t)(row0 + ai * HALF + m * 16) * ldc + col0;
                    const f32x4 a0 = acc[ai][0][m][0], a1 = acc[ai][0][m][1], b0 = acc[ai][1][m][0], b1 = acc[ai][1][m][1];
                    const float av[8] = {a0[0], a0[1], a0[2], a0[3], a1[0], a1[1], a1[2], a1[3]}, bv[8] = {b0[0], b0[1], b0[2], b0[3], b1[0], b1[1], b1[2], b1[3]};
                    float e[8], o[8];
#pragma unroll
                    for (int j = 0; j < 8; ++j) e[j] = __builtin_amdgcn_exp2f(-av[j]);
#pragma unroll
                    for (int j = 0; j < 8; ++j) e[j] = 1.0f + e[j];
#pragma unroll
                    for (int j = 0; j < 8; ++j) e[j] = __builtin_amdgcn_rcpf(e[j]);
#pragma unroll
                    for (int j = 0; j < 8; ++j) o[j] = (av[j] * bv[j]) * e[j];
                    u32x4 w; w.x = cvt_pk_bf16(o[0], o[1]); w.y = cvt_pk_bf16(o[2], o[3]); w.z = cvt_pk_bf16(o[4], o[5]); w.w = cvt_pk_bf16(o[6], o[7]);
                    *(PG8_GAS u32x4*)rowp = w;
                }
        } else {
            bf16_t* base = O; int ld = ldc; int colt = u.pn * BM;
            if constexpr (MODE == 1) { if (u.pn >= 11) { base = O3; ld = 768; colt = (u.pn - 11) * BM; } else if (u.pn >= 8) { base = O2; ld = 768; colt = (u.pn - 8) * BM; } }
            const int col0 = colt + wc * 32 + 8 * fq;
#pragma unroll
            for (int ai = 0; ai < 2; ++ai) {
                float rsc[4]; u32x4 gg[4][2], qq[4][2];
#pragma unroll
                for (int m = 0; m < 4; ++m) {
                    const int row = row0 + ai * HALF + m * 16;
                    rsc[m] = 1.f; if constexpr (MODE == 2) rsc[m] = *(const PG8_GAS float*)(rs + row);
#pragma unroll
                    for (int bj = 0; bj < 2; ++bj) {
                        if constexpr (MODE == 3) {
                            gg[m][bj] = *(const PG8_GAS u32x4*)(Gt + (size_t)row * 2048 + (add ? 1024 : 0) + col0 + bj * HALF);
                            if (add) qq[m][bj] = *(const PG8_GAS u32x4*)(base + (size_t)row * ld + col0 + bj * HALF);
                        }
                    }
                }
                asm volatile("" ::: "memory");
#pragma unroll
                for (int m = 0; m < 4; ++m) {
                    const int row = row0 + ai * HALF + m * 16;
#pragma unroll
                    for (int bj = 0; bj < 2; ++bj) {
                        bf16_t* p = base + (size_t)row * ld + col0 + bj * HALF;
                        f32x4 v0 = acc[ai][bj][m][0], v1 = acc[ai][bj][m][1];
                        if constexpr (MODE == 2) { v0 = v0 * rsc[m]; v1 = v1 * rsc[m]; }
                        if constexpr (MODE == 3) {
                            const u32x4 g = gg[m][bj];
                            float e[8] = {bf_lo(g.x), bf_hi(g.x), bf_lo(g.y), bf_hi(g.y), bf_lo(g.z), bf_hi(g.z), bf_lo(g.w), bf_hi(g.w)};
#pragma unroll
                            for (int j = 0; j < 8; ++j) e[j] = __builtin_amdgcn_exp2f(-e[j]);
#pragma unroll
                            for (int j = 0; j < 8; ++j) e[j] = 1.0f + e[j];
#pragma unroll
                            for (int j = 0; j < 8; ++j) e[j] = __builtin_amdgcn_rcpf(e[j]);
                            v0[0] *= e[0]; v0[1] *= e[1]; v0[2] *= e[2]; v0[3] *= e[3]; v1[0] *= e[4]; v1[1] *= e[5]; v1[2] *= e[6]; v1[3] *= e[7];
                            if (add) {
                                const u32x4 q = qq[m][bj];
                                v0[0] += bf_lo(q.x); v0[1] += bf_hi(q.x); v0[2] += bf_lo(q.y); v0[3] += bf_hi(q.y);
                                v1[0] += bf_lo(q.z); v1[1] += bf_hi(q.z); v1[2] += bf_lo(q.w); v1[3] += bf_hi(q.w);
                            }
                        }
                        u32x4 w; w.x = cvt_pk_bf16(v0[0], v0[1]); w.y = cvt_pk_bf16(v0[2], v0[3]); w.z = cvt_pk_bf16(v1[0], v1[1]); w.w = cvt_pk_bf16(v1[2], v1[3]);
                        *(PG8_GAS u32x4*)p = w;
                    }
                }
                asm volatile("" ::: "memory");
            }
        }
    }
};
struct EpiRes {
    static constexpr bool PERM = false, AFTER_DRAIN = false;
    const void* base; void* out; const float* gate; float coef; int row_off; int in_bf, out_bf;
    __device__ __forceinline__ void operator()(const f32x4 (&acc)[2][2][4][2], const Unit& u, int wr, int wc, int fr, int fq) const {
        typedef unsigned u32x2 __attribute__((ext_vector_type(2)));
        const int b = (u.pm * BM + row_off) >> 11;
        const int col0 = u.pn * BM + wc * 32 + 4 * fq;
        f32x4 gv[2][2];
#pragma unroll
        for (int bj = 0; bj < 2; ++bj)
#pragma unroll
            for (int n = 0; n < 2; ++n) gv[bj][n] = *(const PG8_GAS f32x4*)(gate + (size_t)b * 9216 + col0 + bj * HALF + n * 16) * coef;
#pragma unroll
        for (int ai = 0; ai < 2; ++ai)
#pragma unroll
            for (int mh = 0; mh < 2; ++mh) {
                u32x4 raw[2][2][2];
#pragma unroll
                for (int mm = 0; mm < 2; ++mm) {
                    const size_t off = (size_t)(u.pm * BM + ai * HALF + wr * 64 + (2 * mh + mm) * 16 + fr) * 1024 + col0;
#pragma unroll
                    for (int bj = 0; bj < 2; ++bj)
#pragma unroll
                        for (int n = 0; n < 2; ++n) {
                            const size_t o = off + bj * HALF + n * 16;
                            if (in_bf) { const u32x2 w = *(const PG8_GAS u32x2*)((const bf16_t*)base + o); raw[mm][bj][n].x = w.x; raw[mm][bj][n].y = w.y; }
                            else raw[mm][bj][n] = *(const PG8_GAS u32x4*)((const float*)base + o);
                        }
                }
                asm volatile("" ::: "memory");
#pragma unroll
                for (int mm = 0; mm < 2; ++mm) {
                    const int m = 2 * mh + mm;
                    const size_t off = (size_t)(u.pm * BM + ai * HALF + wr * 64 + m * 16 + fr) * 1024 + col0;
#pragma unroll
                    for (int bj = 0; bj < 2; ++bj)
#pragma unroll
                        for (int n = 0; n < 2; ++n) {
                            const size_t o = off + bj * HALF + n * 16;
                            const u32x4 w4 = raw[mm][bj][n];
                            f32x4 bs;
                            if (in_bf) bs = (f32x4){bf_lo(w4.x), bf_hi(w4.x), bf_lo(w4.y), bf_hi(w4.y)};
                            else bs = (f32x4){__uint_as_float(w4.x), __uint_as_float(w4.y), __uint_as_float(w4.z), __uint_as_float(w4.w)};
                            const f32x4 r = bs + gv[bj][n] * acc[ai][bj][m][n];
                            if (out_bf) { u32x2 w; w.x = cvt_pk_bf16(r[0], r[1]); w.y = cvt_pk_bf16(r[2], r[3]); *(PG8_GAS u32x2*)((bf16_t*)out + o) = w; }
                            else *(PG8_GAS f32x4*)((float*)out + o) = r;
                        }
                }
                asm volatile("" ::: "memory");
            }
    }
};

template <class Epi, class Sched, bool ALIGN_EPI = false, bool SP2 = false>
__device__ __forceinline__ void gemm_phase(PG8_LAS unsigned char* lds, const Gemm g, const Sched& S, const Epi& E, const int tid) {
    const int wid = __builtin_amdgcn_readfirstlane(tid >> 6), lane = tid & 63, wr = wid >> 2, wc = wid & 3, fr = lane & 15, fq = lane >> 4;
    const int K = g.K, lda = g.lda, nt = K / BK;
    unsigned voffA[2], voffB[2];
#pragma unroll
    for (int i = 0; i < 2; ++i) { int R, C; stage_rc(tid * 16 + i * 8192, R, C); const int Rb = Epi::PERM ? ((R & ~31) + perm32(R & 31)) : R;
        voffA[i] = (unsigned)(R * lda + C) * 2u; voffB[i] = (unsigned)(Rb * K + C) * 2u; }
    const size_t kstep = (size_t)(BK * 2);
    const size_t hstepA = (size_t)HALF * lda * 2, hstepB = (size_t)HALF * K * 2;
    const size_t tstepA = 2 * hstepA, tstepB = 2 * hstepB;
    const unsigned ldsw = (unsigned)wid * 1024u;
    const int aoff = lds_byte(wr * 64 + fr, fq * 8), boff = lds_byte(wc * 32 + fr, fq * 8);
#define PG8_SA(b, h) (((b) * 2 + (h)) * HTB)
#define PG8_SB(b, h) ((4 + (b) * 2 + (h)) * HTB)
#define PG8_STAGE(bufoff, gbase, voff) do { _Pragma("unroll") for (int _i = 0; _i < 2; ++_i) \
        __builtin_amdgcn_global_load_lds((const unsigned*)((const char*)(gbase) + (voff)[_i]), (PG8_LAS unsigned*)(lds + (bufoff) + ldsw + _i * 8192), 16, 0, 0); } while (0)
#define PG8_LDA(dst, b, h) do { _Pragma("unroll") for (int m = 0; m < 4; ++m) _Pragma("unroll") for (int k = 0; k < 2; ++k) dst[m][k] = *(const PG8_LAS bf16x8*)(lds + PG8_SA(b, h) + aoff + m * 2048 + k * 1024); } while (0)
#define PG8_LDB(dst, b, h) do { _Pragma("unroll") for (int n = 0; n < 2; ++n) _Pragma("unroll") for (int k = 0; k < 2; ++k) dst[n][k] = *(const PG8_LAS bf16x8*)(lds + PG8_SB(b, h) + boff + n * 2048 + k * 1024); } while (0)
#define PG8_MMA(ai, bj, At, Bt) do { __builtin_amdgcn_s_setprio(1); _Pragma("unroll") for (int m = 0; m < 4; ++m) _Pragma("unroll") for (int n = 0; n < 2; ++n) _Pragma("unroll") for (int k = 0; k < 2; ++k) \
        acc[ai][bj][m][n] = __builtin_amdgcn_mfma_f32_16x16x32_bf16(Bt[n][k], At[m][k], acc[ai][bj][m][n], 0, 0, 0); __builtin_amdgcn_s_setprio(0); } while (0)
#define PG8_WAIT_V(n) asm volatile("s_waitcnt vmcnt(" #n ")" ::: "memory")
#define PG8_WAIT_L(n) asm volatile("s_waitcnt lgkmcnt(" #n ")" ::: "memory")
#define PG8_BAR __builtin_amdgcn_s_barrier()
#define PG8_SCHED __builtin_amdgcn_sched_barrier(0)
    Unit cur, nxt; int ui = 0;
    if (!S.next(0, cur)) return;
    f32x4 acc[2][2][4][2];
#pragma unroll
    for (int a = 0; a < 2; ++a)
#pragma unroll
        for (int b = 0; b < 2; ++b)
#pragma unroll
            for (int m = 0; m < 4; ++m)
#pragma unroll
                for (int n = 0; n < 2; ++n) acc[a][b][m][n] = (f32x4){0.f, 0.f, 0.f, 0.f};
    bf16x8 At[4][2], B0[2][2], B1[2][2];
    const char* cA = (const char*)g.A + (size_t)cur.pm * tstepA; const char* cB = (const char*)g.Bt + (size_t)cur.pn * tstepB;
    S.a_ready(cur);
    if constexpr (SP2) {
        PG8_STAGE(PG8_SB(0, 0), cB, voffB); PG8_STAGE(PG8_SB(0, 1), cB + hstepB, voffB); PG8_STAGE(PG8_SA(0, 0), cA, voffA); PG8_STAGE(PG8_SA(0, 1), cA + hstepA, voffA);
        if (wr == 1) PG8_BAR;
        PG8_WAIT_V(2); PG8_BAR;
        PG8_STAGE(PG8_SB(1, 0), cB + kstep, voffB); PG8_STAGE(PG8_SA(1, 0), cA + kstep, voffA); PG8_STAGE(PG8_SB(1, 1), cB + hstepB + kstep, voffB);
        PG8_WAIT_V(6); PG8_BAR;
    } else {
        PG8_STAGE(PG8_SB(0, 0), cB, voffB); PG8_STAGE(PG8_SA(0, 0), cA, voffA); PG8_STAGE(PG8_SB(0, 1), cB + hstepB, voffB); PG8_STAGE(PG8_SA(0, 1), cA + hstepA, voffA);
        if (wr == 1) PG8_BAR;
        PG8_WAIT_V(4); PG8_BAR;
        PG8_STAGE(PG8_SB(1, 0), cB + kstep, voffB); PG8_STAGE(PG8_SA(1, 0), cA + kstep, voffA); PG8_STAGE(PG8_SB(1, 1), cB + hstepB + kstep, voffB);
        PG8_WAIT_V(6); PG8_BAR;
    }
    for (;;) {
        const bool has_next = S.next(ui + 1, nxt);
        const char* nA = has_next ? (const char*)g.A + (size_t)nxt.pm * tstepA : cA; const char* nB = has_next ? (const char*)g.Bt + (size_t)nxt.pn * tstepB : cB;
        for (int t = 0; t < nt; t += 2) {
            const bool last = (t == nt - 2);
            const char* a1 = cA + (size_t)(t + 1) * kstep;
            const char* a2 = last ? nA : cA + (size_t)(t + 2) * kstep; const char* b2 = last ? nB : cB + (size_t)(t + 2) * kstep;
            const char* a3 = a2 + kstep; const char* b3 = b2 + kstep;
            if (last && has_next) S.a_ready(nxt);
            if constexpr (SP2) {
            PG8_LDB(B0, 0, 0); PG8_LDB(B1, 0, 1); PG8_SCHED; PG8_LDA(At, 0, 0); PG8_STAGE(PG8_SA(1, 1), a1 + hstepA, voffA);
            PG8_WAIT_V(8); PG8_WAIT_L(0); PG8_BAR; PG8_MMA(0, 0, At, B0); PG8_MMA(0, 1, At, B1); PG8_BAR; PG8_SCHED;
            PG8_LDA(At, 0, 1); PG8_STAGE(PG8_SB(0, 0), b2, voffB); PG8_STAGE(PG8_SB(0, 1), b2 + hstepB, voffB); PG8_STAGE(PG8_SA(0, 0), a2, voffA);
            PG8_WAIT_V(8); PG8_WAIT_L(0); PG8_BAR; PG8_MMA(1, 0, At, B0); PG8_MMA(1, 1, At, B1); PG8_BAR; PG8_SCHED;
            PG8_LDB(B0, 1, 0); PG8_LDB(B1, 1, 1); PG8_SCHED; PG8_LDA(At, 1, 0); PG8_STAGE(PG8_SA(0, 1), a2 + hstepA, voffA);
            PG8_WAIT_V(8); PG8_WAIT_L(0); PG8_BAR; PG8_MMA(0, 0, At, B0); PG8_MMA(0, 1, At, B1); PG8_BAR; PG8_SCHED;
            PG8_LDA(At, 1, 1); PG8_STAGE(PG8_SB(1, 0), b3, voffB); PG8_STAGE(PG8_SB(1, 1), b3 + hstepB, voffB); PG8_STAGE(PG8_SA(1, 0), a3, voffA);
            PG8_WAIT_V(8); PG8_WAIT_L(0); PG8_BAR; PG8_MMA(1, 0, At, B0); PG8_MMA(1, 1, At, B1); PG8_BAR; PG8_SCHED;
            } else {
            PG8_LDB(B0, 0, 0); PG8_SCHED; PG8_LDA(At, 0, 0); PG8_STAGE(PG8_SA(1, 1), a1 + hstepA, voffA);
            PG8_WAIT_L(8); PG8_BAR; PG8_WAIT_L(0); PG8_MMA(0, 0, At, B0); PG8_BAR; PG8_SCHED;
            PG8_LDB(B1, 0, 1); PG8_STAGE(PG8_SB(0, 0), b2, voffB);
            PG8_BAR; PG8_WAIT_L(0); PG8_MMA(0, 1, At, B1); PG8_BAR;
            PG8_LDA(At, 0, 1); PG8_STAGE(PG8_SA(0, 0), a2, voffA);
            PG8_BAR; PG8_WAIT_L(0); PG8_MMA(1, 0, At, B0); PG8_BAR; PG8_SCHED;
            PG8_STAGE(PG8_SB(0, 1), b2 + hstepB, voffB);
            PG8_WAIT_V(6); PG8_BAR; PG8_MMA(1, 1, At, B1); PG8_BAR;
            PG8_LDB(B0, 1, 0); PG8_SCHED; PG8_LDA(At, 1, 0); PG8_STAGE(PG8_SA(0, 1), a2 + hstepA, voffA);
            PG8_WAIT_L(8); PG8_BAR; PG8_WAIT_L(0); PG8_MMA(0, 0, At, B0); PG8_BAR; PG8_SCHED;
            PG8_LDB(B1, 1, 1); PG8_STAGE(PG8_SB(1, 0), b3, voffB);
            PG8_BAR; PG8_WAIT_L(0); PG8_MMA(0, 1, At, B1); PG8_BAR;
            PG8_LDA(At, 1, 1); PG8_STAGE(PG8_SA(1, 0), a3, voffA);
            PG8_BAR; PG8_WAIT_L(0); PG8_MMA(1, 0, At, B0); PG8_BAR; PG8_SCHED;
            PG8_STAGE(PG8_SB(1, 1), b3 + hstepB, voffB);
            PG8_WAIT_V(6); PG8_BAR; PG8_MMA(1, 1, At, B1); PG8_BAR;
            }
        }
        if constexpr (ALIGN_EPI) { if (wr == 0) PG8_BAR; }
        if constexpr (!Epi::AFTER_DRAIN) { E(acc, cur, wr, wc, fr, fq); S.done(cur); }
        if (!has_next) break;
#pragma unroll
        for (int a = 0; a < 2; ++a)
#pragma unroll
            for (int b = 0; b < 2; ++b)
#pragma unroll
                for (int m = 0; m < 4; ++m)
#pragma unroll
                    for (int n = 0; n < 2; ++n) acc[a][b][m][n] = (f32x4){0.f, 0.f, 0.f, 0.f};
        cur = nxt; cA = nA; cB = nB; ++ui;
        if constexpr (ALIGN_EPI) { if (wr == 1) PG8_BAR; }
    }
    PG8_WAIT_V(0);
    if constexpr (!ALIGN_EPI) { if (wr == 0) PG8_BAR; }
    PG8_BAR;
    if constexpr (Epi::AFTER_DRAIN) { E.fused(acc, cur, wr, wc, fr, fq, lds, wid, lane); S.done(cur); }
#undef PG8_SA
#undef PG8_SB
#undef PG8_STAGE
#undef PG8_LDA
#undef PG8_LDB
#undef PG8_MMA
#undef PG8_WAIT_V
#undef PG8_WAIT_L
#undef PG8_BAR
#undef PG8_SCHED
}
}

#define LAS __attribute__((address_space(3)))
#define GASP __attribute__((address_space(1)))
typedef unsigned short bf16;
typedef unsigned v4u __attribute__((ext_vector_type(4)));
typedef unsigned v2u __attribute__((ext_vector_type(2)));
typedef float f32x2 __attribute__((ext_vector_type(2)));
typedef float f32x4 __attribute__((ext_vector_type(4)));
typedef float f32x16 __attribute__((ext_vector_type(16)));
typedef short bf16x8 __attribute__((ext_vector_type(8)));

constexpr int NWAVES = 8, NTHR = 512;
constexpr int BATCH = 32, SEQ = 2048, DM = 1024, DEPTH = 2, TOK = BATCH * SEQ, FF = 2816, NMODC = 9216;
constexpr int TH = TOK / 2;
constexpr float EPS = 1e-6f;
constexpr float QS_G = 0.125f * 1.4426950408889634f;
constexpr float QS_M = 0.10206207261596575f * 1.4426950408889634f;
constexpr int LDS_BYTES = 147456;

constexpr size_t MiB = 1u << 20;
constexpr size_t WS_MOD = 0, WS_CS = 3 * MiB, WS_RSQ = WS_CS + 262144, WS_RSKV = WS_RSQ + 131072;
constexpr size_t WS_BAR = WS_RSKV + 131072;
constexpr size_t WS_WT = 4 * MiB, WS_U = 100 * MiB, WS_X = 228 * MiB;
constexpr size_t WS_HID = WS_X;
constexpr size_t ARENA = (size_t)8192 * FF * 2, AR_G = 0, AR_ZG = 16 * MiB, AR_ZM = 22 * MiB, AR_QRAW = 28 * MiB, AR_KVRAW = 34 * MiB;
static_assert(AR_KVRAW + (size_t)4096 * 1024 * 2 <= ARENA && 8 * ARENA == (size_t)TOK * FF * 2, "arena map");
constexpr size_t WS_Y = 580 * MiB;
constexpr size_t WS_QG = WS_Y, WS_KG = WS_Y + 32 * MiB, WS_VTG = WS_Y + 40 * MiB, WS_QM = WS_Y + 48 * MiB, WS_KM = WS_Y + 96 * MiB, WS_VTM = WS_Y + 144 * MiB,
                 WS_OM = WS_Y + 176 * MiB, WS_OG = WS_Y + 208 * MiB, WS_MG = WS_Y + 240 * MiB, WS_H = WS_Y + 304 * MiB  , WS_END = WS_Y + 432 * MiB;
static_assert(WS_HID + (size_t)TOK * FF * 2 <= WS_Y, "ws map");
constexpr size_t LW = 23625728;
static_assert(WS_WT + 2 * LW * 2 <= WS_U, "weights fit");

struct Frame {
    LAS unsigned char* lds;
    int tid, lane, wave, vcu, G, bx;
    int xid, xr, nx;
};

__device__ __forceinline__ float wave_sum(float v) {
#pragma unroll
    for (int o = 1; o < 64; o <<= 1) v += __shfl_xor(v, o);
    return v;
}
template <class T> __device__ __forceinline__ T* uni(T* p) {
    const unsigned long long v = (unsigned long long)p;
    const unsigned lo = __builtin_amdgcn_readfirstlane((unsigned)v), hi = __builtin_amdgcn_readfirstlane((unsigned)(v >> 32));
    return (T*)(((unsigned long long)hi << 32) | lo);
}
__device__ __forceinline__ float bf2f(bf16 v) { return __uint_as_float((unsigned)v << 16); }
__device__ __forceinline__ unsigned f2bf(float f) { unsigned u = __float_as_uint(f); return (u + 0x7fffu + ((u >> 16) & 1u)) >> 16; }
__device__ __forceinline__ unsigned pk2(float lo, float hi) { return f2bf(lo) | (f2bf(hi) << 16); }

__device__ __forceinline__ void mat_info(int mat, int& K, int& Nd, int& Ns, size_t& off, int& in_idx, int& gain_idx) {
    gain_idx = -1;
    switch (mat) {
        case 0: K = 1024; Nd = 5632; Ns = 5632; off = 0; in_idx = 5; break;
        case 1: K = 2816; Nd = 1024; Ns = 1024; off = 5767168; in_idx = 6; break;
        case 2: K = 1024; Nd = 3584; Ns = 3488; off = 8650752; in_idx = 8; break;
        case 3: K = 384; Nd = 768; Ns = 768; off = 12320768; in_idx = 10; gain_idx = 9; break;
        case 4: K = 256; Nd = 1024; Ns = 1024; off = 12615680; in_idx = 12; gain_idx = 11; break;
        case 5: K = 512; Nd = 1024; Ns = 1024; off = 12877824; in_idx = 17; break;
        case 6: K = 512; Nd = 1024; Ns = 1024; off = 13402112; in_idx = 18; break;
        case 7: K = 1024; Nd = 1024; Ns = 1024; off = 13926400; in_idx = 19; break;
        case 8: K = 1024; Nd = 5632; Ns = 5632; off = 14974976; in_idx = 21; break;
        default: K = 2816; Nd = 1024; Ns = 1024; off = 20742144; in_idx = 22; break;
    }
}
__device__ __forceinline__ int mat_items(int mat) {
    switch (mat) { case 0: case 8: return 2816; case 1: case 9: return 1408; case 2: return 1792; case 3: return 144; case 4: return 128; case 5: case 6: return 256; default: return 512; }
}
constexpr int ITEMS_PER_LAYER = 2816 + 1408 + 1792 + 144 + 128 + 256 + 256 + 512 + 2816 + 1408;

__device__ __forceinline__ void cvt_item(const float* W, int K, int Ns, int src0, const float* gain, float cscale, bf16* WT, int n0, int k0, LAS float* scr, int lane) {
    float v_[32];
#pragma unroll
    for (int i = 0; i < 32; ++i) {
        const int kk = 2 * i + (lane >> 5);
        v_[i] = 0.f;
        if (src0 >= 0) v_[i] = W[(size_t)(k0 + kk) * Ns + src0 + (lane & 31)];
    }
#pragma unroll
    for (int i = 0; i < 32; ++i) {
        const int kk = 2 * i + (lane >> 5);
        float v = v_[i] * cscale;
        if (gain) v *= gain[k0 + kk];
        scr[kk * 33 + (lane & 31)] = v;
    }
    asm volatile("s_waitcnt lgkmcnt(0)" ::: "memory");
    const int c = lane & 7;
#pragma unroll
    for (int j = 0; j < 4; ++j) {
        const int n = (lane >> 3) + 8 * j; const LAS float* s = scr + (8 * c) * 33 + n;
        v4u o; o.x = pk2(s[0 * 33], s[1 * 33]); o.y = pk2(s[2 * 33], s[3 * 33]); o.z = pk2(s[4 * 33], s[5 * 33]); o.w = pk2(s[6 * 33], s[7 * 33]);
        *(v4u*)(WT + (size_t)(n0 + n) * K + k0 + 8 * c) = o;
    }
    asm volatile("s_waitcnt lgkmcnt(0)" ::: "memory");
}

struct Args { const float* in[23]; float* out; unsigned char* ws; int pad[2]; };
__device__ __forceinline__ const float* in_sel(const Args& a, int idx) {
    switch (idx) {
        case 5: return uni(a.in[5]); case 6: return uni(a.in[6]); case 8: return uni(a.in[8]); case 9: return uni(a.in[9]); case 10: return uni(a.in[10]); case 11: return uni(a.in[11]); case 12: return uni(a.in[12]);
        case 17: return uni(a.in[17]); case 18: return uni(a.in[18]); case 19: return uni(a.in[19]); case 21: return uni(a.in[21]); default: return uni(a.in[22]);
    }
}
__device__ __forceinline__ void p0_prologue(Frame& F, const Args& A, unsigned char* ws) {
    LAS float* scr = (LAS float*)(F.lds + F.wave * 16384);
    const int gw = F.vcu * NWAVES + F.wave, NGW = F.G * NWAVES;
    bf16* WT = (bf16*)(ws + WS_WT);
    for (int it = gw; it < DEPTH * ITEMS_PER_LAYER; it += NGW) {
        const int l = it / ITEMS_PER_LAYER; int r = it % ITEMS_PER_LAYER; int mat = 0;
        for (;;) { const int n = mat_items(mat); if (r < n) break; r -= n; ++mat; }
        int K, Nd, Ns, in_idx, gain_idx; size_t off; mat_info(mat, K, Nd, Ns, off, in_idx, gain_idx);
        const int nblk = Nd / 32, kb = r / nblk, nb = r % nblk, n0 = nb * 32, k0 = kb * 64;
        int src0 = n0; float cscale = 1.0f;
        if (mat == 0 || mat == 8) { const int pn = n0 >> 8, rr = n0 & 255, bj = rr >> 7, cc = rr & 127; src0 = bj * FF + 128 * pn + cc; cscale = bj == 0 ? 1.4426950408889634f : 0.6931471805599453f; }
        else if (mat == 2) { src0 = (n0 < 2048) ? 1440 + n0 : (n0 < 2816) ? 672 + (n0 - 2048) : (n0 < 3488) ? (n0 - 2816) : -1; if (n0 < 2048) cscale = 1.4426950408889634f; }
        const float* W = in_sel(A, in_idx) + (size_t)l * K * Ns;
        const float* gain = gain_idx >= 0 ? in_sel(A, gain_idx) + (size_t)l * K : nullptr;
        cvt_item(W, K, Ns, src0, gain, cscale, WT + (size_t)l * LW + off, n0, k0, scr, F.lane);
    }
    {
        f32x2* CS = (f32x2*)(ws + WS_CS);
        for (int idx = (F.vcu * NTHR + F.tid); idx < 2048 * 16; idx += F.G * NTHR) {
            const int pos = idx >> 4, i = idx & 15;
            const float inv = exp2f(-(float)i * (13.287712379549449f / 16.0f));
            const float ang = (float)pos * inv;
            const double rev = (double)ang * 0.15915494309189535;
            const float fr = (float)(rev - __builtin_rint(rev));
            CS[idx] = (f32x2){__builtin_amdgcn_cosf(fr), __builtin_amdgcn_sinf(fr)};
        }
    }
    __syncthreads();
    {
        LAS float* cs = (LAS float*)F.lds;
        const float* c = uni(A.in[1]);
        float* mod = (float*)(ws + WS_MOD);
        for (int it = F.vcu; it < DEPTH * (NMODC / 64); it += F.G) {
            for (int idx = F.tid; idx < 32 * 1024; idx += NTHR) { const int k = idx >> 5, b = idx & 31; const float v = c[b * 1024 + k]; cs[idx] = v / (1.0f + __expf(-v)); }
            __syncthreads();
            const int l = it / (NMODC / 64), jb = it % (NMODC / 64), col = jb * 64 + F.lane;
            const float* w = uni(A.in[2]) + (size_t)l * 1024 * NMODC + col;
            float acc[32];
#pragma unroll
            for (int b = 0; b < 32; ++b) acc[b] = 0.f;
            const int kbeg = F.wave * 128;
#pragma unroll 4
            for (int k = kbeg; k < kbeg + 128; ++k) {
                const float wv = w[(size_t)k * NMODC];
                const LAS f32x4* cr = (const LAS f32x4*)(cs + k * 32);
#pragma unroll
                for (int b4 = 0; b4 < 8; ++b4) { const f32x4 cv = cr[b4]; acc[4 * b4] += cv[0] * wv; acc[4 * b4 + 1] += cv[1] * wv; acc[4 * b4 + 2] += cv[2] * wv; acc[4 * b4 + 3] += cv[3] * wv; }
            }
            __syncthreads();
            LAS float* red = (LAS float*)F.lds;
#pragma unroll
            for (int b = 0; b < 32; ++b) red[(F.wave * 32 + b) * 64 + F.lane] = acc[b];
            __syncthreads();
#pragma unroll
            for (int q = 0; q < 4; ++q) {
                const int idx = F.tid + NTHR * q, b = idx >> 6, cc = idx & 63;
                float sum = uni(A.in[3])[(size_t)l * NMODC + jb * 64 + cc];
#pragma unroll
                for (int wv = 0; wv < 8; ++wv) sum += red[(wv * 32 + b) * 64 + cc];
                mod[((size_t)l * 32 + b) * NMODC + jb * 64 + cc] = sum;
            }
            __syncthreads();
        }
    }
}

template <int CTRL> __device__ __forceinline__ float dppf(float v) { return __builtin_bit_cast(float, __builtin_amdgcn_update_dpp(0, __builtin_bit_cast(int, v), CTRL, 0xF, 0xF, true)); }
__device__ __forceinline__ float row8_sum(float v) { v += dppf<0xB1>(v); v += dppf<0x4E>(v); v += dppf<0x141>(v); return v; }
__device__ __forceinline__ float row16_sum(float v) { v = row8_sum(v); v += dppf<0x140>(v); return v; }
__device__ __forceinline__ f32x4 ld4bf(const bf16* p) { const v2u w = *(const GASP v2u*)p; return (f32x4){__uint_as_float(w.x << 16), __uint_as_float(w.x & 0xffff0000u), __uint_as_float(w.y << 16), __uint_as_float(w.y & 0xffff0000u)}; }
__device__ __forceinline__ f32x4 up4(v2u w) { return (f32x4){__uint_as_float(w.x << 16), __uint_as_float(w.x & 0xffff0000u), __uint_as_float(w.y << 16), __uint_as_float(w.y & 0xffff0000u)}; }
__device__ __forceinline__ v2u pk4(f32x4 v) { v2u w; w.x = pk2(v[0], v[1]); w.y = pk2(v[2], v[3]); return w; }
__device__ __forceinline__ float dot4(f32x4 x) { return (x[0] * x[0] + x[1] * x[1]) + (x[2] * x[2] + x[3] * x[3]); }
__device__ __forceinline__ f32x4 rope4(f32x4 y, f32x4 cA, f32x4 cB, bool hi) {
    f32x4 p; p[0] = __shfl_xor(y[0], 4); p[1] = __shfl_xor(y[1], 4); p[2] = __shfl_xor(y[2], 4); p[3] = __shfl_xor(y[3], 4);
    if (!hi) p = -p;
    return (f32x4){y[0] * cA[0] + p[0] * cA[1], y[1] * cA[2] + p[1] * cA[3], y[2] * cB[0] + p[2] * cB[1], y[3] * cB[2] + p[3] * cB[3]};
}

__device__ __forceinline__ void norm_phase(Frame& F, const void* h, int h_bf, const float* gain, const float* sh, const float* sc, bf16* U) {
    const int lw = F.xr * NWAVES + F.wave, NLW = F.nx * NWAVES;
    for (int lb = lw; lb < 256; lb += NLW) {
        const int blk = 256 * F.xid + lb;
        const int m0 = blk * 32, b = m0 >> 11;
        f32x4 A[4], B[4];
#pragma unroll
        for (int j = 0; j < 4; ++j) {
            const int col = 256 * j + 4 * F.lane;
            A[j] = *(const GASP f32x4*)(gain + col) * (*(const GASP f32x4*)(sc + (size_t)b * NMODC + col) + 1.0f);
            B[j] = *(const GASP f32x4*)(sh + (size_t)b * NMODC + col);
        }
#pragma unroll 4
        for (int r = 0; r < 32; ++r) {
            const int m = m0 + r;
            f32x4 v[4]; float s = 0.f;
            if (h_bf) {
                const bf16* xr = (const bf16*)h + (size_t)m * DM + 4 * F.lane;
#pragma unroll
                for (int j = 0; j < 4; ++j) { v[j] = ld4bf(xr + 256 * j); s += dot4(v[j]); }
            } else {
                const f32x4* xr = (const f32x4*)((const float*)h + (size_t)m * DM) + F.lane;
#pragma unroll
                for (int j = 0; j < 4; ++j) { v[j] = *(const GASP f32x4*)(xr + 64 * j); s += dot4(v[j]); }
            }
            s = row16_sum(s); s += __shfl_xor(s, 16); s += __shfl_xor(s, 32);
            const float rstd = rsqrtf(s * (1.f / DM) + EPS);
            v2u* o8 = (v2u*)(U + (size_t)m * DM) + F.lane;
#pragma unroll
            for (int j = 0; j < 4; ++j) *(GASP v2u*)(o8 + 64 * j) = pk4(v[j] * rstd * A[j] + B[j]);
        }
    }
}

__device__ __forceinline__ void pp1_phase(Frame& F, unsigned char* ws, const bf16* ZG, const bf16* ZM, const float* gqn, const float* gkn) {
    float* RSQ = (float*)(ws + WS_RSQ); float* RSKV = (float*)(ws + WS_RSKV);
    bf16* QG = (bf16*)(ws + WS_QG); bf16* KG = (bf16*)(ws + WS_KG); bf16* VTG = (bf16*)(ws + WS_VTG);
    const float* CS = (const float*)(ws + WS_CS);
    const int lane = F.lane, a = lane & 15;
    const f32x4 gq4 = *(const GASP f32x4*)(gqn + 4 * a), gk4 = *(const GASP f32x4*)(gkn + 4 * a);
    const bool hi = (a & 4) != 0;
    LAS bf16* stage = (LAS bf16*)F.lds;
    for (int lc = F.xr; lc < 64; lc += F.nx) {
        const int ch = 64 * F.xid + lc;
        const int lr0 = ch * 64, bl = lr0 >> 11, s0 = lr0 & 2047;
#pragma unroll 1
        for (int i0 = 0; i0 < 8; i0 += 4) {
            v2u zq0[4], zq1[4], zkv[4], rw[4][3]; f32x4 cAa[4], cBa[4];
#pragma unroll
            for (int u = 0; u < 4; ++u) {
                const int tk = F.wave * 8 + i0 + u, lr = lr0 + tk, s = s0 + tk;
                const bf16* zg = ZG + (size_t)lr * 768; const bf16* zm = ZM + (size_t)lr * 768;
                zq0[u] = *(const GASP v2u*)(zm + 4 * lane); zq1[u] = (v2u){0u, 0u}; if (lane < 32) zq1[u] = *(const GASP v2u*)(zm + 256 + 4 * lane);
                zkv[u] = *(const GASP v2u*)(zm + 384 + 4 * lane);
                const int pos = (a < 8) ? (s >> 6) : (s & 63);
                cAa[u] = *(const GASP f32x4*)(CS + (pos * 16 + 4 * (a & 3)) * 2); cBa[u] = *(const GASP f32x4*)(CS + (pos * 16 + 4 * (a & 3)) * 2 + 4);
#pragma unroll
                for (int j = 0; j < 3; ++j) rw[u][j] = *(const GASP v2u*)(zg + 256 * j + 4 * lane);
            }
            asm volatile("" ::: "memory");
#pragma unroll
            for (int u = 0; u < 4; ++u) {
                const int tk = F.wave * 8 + i0 + u, lr = lr0 + tk;
                float ss = wave_sum(dot4(up4(zq0[u])) + dot4(up4(zq1[u]))); if (lane == 0) RSQ[lr] = rsqrtf(ss * (1.f / 384.f) + EPS);
                ss = wave_sum(dot4(up4(zkv[u]))); if (lane == 0) RSKV[lr] = rsqrtf(ss * (1.f / 256.f) + EPS);
#pragma unroll
                for (int j = 0; j < 3; ++j) {
                    const v2u raw = rw[u][j];
                    const f32x4 x = up4(raw);
                    const float q = row16_sum(dot4(x));
                    const float r = rsqrtf(q * (1.f / 64.f) + EPS);
                    const f32x4 o = rope4(x * r * (j < 2 ? gq4 : gk4), cAa[u], cBa[u], hi);
                    if (j < 2) *(GASP v2u*)(QG + (size_t)lr * 512 + 256 * j + 4 * lane) = pk4(o * QS_G);
                    else if (lane < 32) *(GASP v2u*)(KG + (size_t)lr * 128 + 4 * lane) = pk4(o);
                    else *(LAS v2u*)(stage + tk * 132 + 4 * (lane - 32)) = raw;
                }
            }
            asm volatile("" ::: "memory");
        }
        __syncthreads();
#pragma unroll
        for (int jj = 0; jj < 2; ++jj) {
            const int it = F.tid + 512 * jj, hd = it >> 3, cc = it & 7;
            unsigned e[8];
#pragma unroll
            for (int j = 0; j < 8; ++j) e[j] = stage[(8 * cc + j) * 132 + hd];
            v4u o; o.x = e[0] | (e[1] << 16); o.y = e[2] | (e[3] << 16); o.z = e[4] | (e[5] << 16); o.w = e[6] | (e[7] << 16);
            *(GASP v4u*)(VTG + ((size_t)(bl * 128 + hd)) * 2048 + s0 + 8 * cc) = o;
        }
        __syncthreads();
    }
}

__device__ __forceinline__ void pp2_phase(Frame& F, unsigned char* ws, const bf16* QRAW, const bf16* KVRAW, const bf16* ZM, const float* gqn, const float* gkn) {
    bf16* QM = (bf16*)(ws + WS_QM); bf16* KM = (bf16*)(ws + WS_KM); bf16* VTM = (bf16*)(ws + WS_VTM);
    const float* CS = (const float*)(ws + WS_CS);
    const int lane = F.lane, a = lane & 15, hh = lane >> 4, a8 = lane & 7, h8 = lane >> 3;
    const f32x4 g0q = *(const GASP f32x4*)(gqn + 4 * a), g1q = *(const GASP f32x4*)(gqn + 64 + 4 * a8), g0k = *(const GASP f32x4*)(gkn + 4 * a), g1k = *(const GASP f32x4*)(gkn + 64 + 4 * a8);
    const bool hi = (a8 & 4) != 0;
    LAS bf16* stage = (LAS bf16*)F.lds;
    for (int lc = F.xr; lc < 64; lc += F.nx) {
        const int ch = 64 * F.xid + lc;
        const int lr0 = ch * 64, bl = lr0 >> 11, s0 = lr0 & 2047;
#pragma unroll 1
        for (int i0 = 0; i0 < 8; i0 += 4) {
            v2u xrw[4], xnw[4][2], krw[4], knw[4][2], vw[4][2]; f32x4 cAa[4], cBa[4];
#pragma unroll
            for (int u = 0; u < 4; ++u) {
                const int tk = F.wave * 8 + i0 + u, lr = lr0 + tk, s = s0 + tk;
                const bf16* qr = QRAW + (size_t)lr * 768; const bf16* kvr = KVRAW + (size_t)lr * 1024; const bf16* zm = ZM + (size_t)lr * 768;
                cAa[u] = *(const GASP f32x4*)(CS + (s * 16 + 4 * (a8 & 3)) * 2); cBa[u] = *(const GASP f32x4*)(CS + (s * 16 + 4 * (a8 & 3)) * 2 + 4);
                xrw[u] = *(const GASP v2u*)(qr + 96 * h8 + 64 + 4 * a8);
                krw[u] = *(const GASP v2u*)(zm + 640 + 4 * a8);
#pragma unroll
                for (int p = 0; p < 2; ++p) {
                    xnw[u][p] = *(const GASP v2u*)(qr + 96 * (4 * p + hh) + 4 * a);
                    knw[u][p] = *(const GASP v2u*)(kvr + 128 * (4 * p + hh) + 4 * a);
                    vw[u][p] = *(const GASP v2u*)(kvr + 128 * (4 * p + hh) + 64 + 4 * a);
                }
            }
            asm volatile("" ::: "memory");
#pragma unroll
            for (int u = 0; u < 4; ++u) {
                const int tk = F.wave * 8 + i0 + u, lr = lr0 + tk;
                const f32x4 cA = cAa[u], cB = cBa[u];
                {
                    const f32x4 xr = up4(xrw[u]);
                    const float ssr = row8_sum(dot4(xr));
                    float rp[2];
#pragma unroll
                    for (int p = 0; p < 2; ++p) {
                        const f32x4 xn = up4(xnw[u][p]);
                        const float ssn = row16_sum(dot4(xn));
                        const float ssrh = __shfl(ssr, 32 * p + 8 * hh);
                        const float r = rsqrtf((ssn + ssrh) * (1.f / 96.f) + EPS); rp[p] = r;
                        *(GASP v2u*)(QM + (size_t)lr * 768 + 96 * (4 * p + hh) + 4 * a) = pk4(xn * g0q * (r * QS_M));
                    }
                    const float r0 = __shfl(rp[0], 16 * (h8 & 3)), r1 = __shfl(rp[1], 16 * (h8 & 3));
                    const float rr = (h8 < 4) ? r0 : r1;
                    const f32x4 o = rope4(xr * g1q * rr, cA, cB, hi);
                    *(GASP v2u*)(QM + (size_t)lr * 768 + 96 * h8 + 64 + 4 * a8) = pk4(o * QS_M);
                }
                {
                    const f32x4 kr = up4(krw[u]);
                    const float sspe = row8_sum(dot4(kr));
                    float rp[2];
#pragma unroll
                    for (int p = 0; p < 2; ++p) {
                        const f32x4 xn = up4(knw[u][p]);
                        const float ssn = row16_sum(dot4(xn));
                        const float r = rsqrtf((ssn + sspe) * (1.f / 96.f) + EPS); rp[p] = r;
                        *(GASP v2u*)(KM + (size_t)lr * 768 + 96 * (4 * p + hh) + 4 * a) = pk4(xn * g0k * r);
                        *(LAS v2u*)(stage + tk * 516 + 64 * (4 * p + hh) + 4 * a) = vw[u][p];
                    }
                    const float r0 = __shfl(rp[0], 16 * (h8 & 3)), r1 = __shfl(rp[1], 16 * (h8 & 3));
                    const float rr = (h8 < 4) ? r0 : r1;
                    const f32x4 o = rope4(kr * g1k * rr, cA, cB, hi);
                    *(GASP v2u*)(KM + (size_t)lr * 768 + 96 * h8 + 64 + 4 * a8) = pk4(o);
                }
            }
            asm volatile("" ::: "memory");
        }
        __syncthreads();
#pragma unroll 2
        for (int jj = 0; jj < 8; ++jj) {
            const int it = F.tid + 512 * jj, hd = it >> 3, cc = it & 7;
            unsigned e[8];
#pragma unroll
            for (int j = 0; j < 8; ++j) e[j] = stage[(8 * cc + j) * 516 + hd];
            v4u o; o.x = e[0] | (e[1] << 16); o.y = e[2] | (e[3] << 16); o.z = e[4] | (e[5] << 16); o.w = e[6] | (e[7] << 16);
            *(GASP v4u*)(VTM + ((size_t)(bl * 512 + hd)) * 2048 + s0 + 8 * cc) = o;
        }
        __syncthreads();
    }
}

typedef __bf16 bf16x2_t __attribute__((ext_vector_type(2)));
__device__ __forceinline__ unsigned cvtpk(float lo, float hi) { const f32x2 v = {lo, hi}; const bf16x2_t b = __builtin_convertvector(v, bf16x2_t); return __builtin_bit_cast(unsigned, b); }
#define ATT_BAR() asm volatile("s_waitcnt lgkmcnt(0)\n\ts_barrier" ::: "memory")
template <int DQ>
__device__ __forceinline__ void attn_unit(LAS unsigned char* lds, const bf16* Qp, int ldq, const bf16* Kp, int ldk, const bf16* Vtp, bf16* Op, int tid, int lane, int wave) {
    constexpr int KP = DQ * 2 + 16, VP = 144, KBUF = 64 * KP, VBUF = 64 * VP, ND = DQ / 16, KCH = DQ / 8, NKC = 64 * KCH, NT = SEQ / 64;
    constexpr bool K2 = NKC > 512;
    constexpr float THR = 8.0f;
    const int q = lane & 31, hi = lane >> 5;
    bf16x8 qf[ND];
#pragma unroll
    for (int d0 = 0; d0 < ND; ++d0) qf[d0] = *(const GASP bf16x8*)(Qp + (size_t)(wave * 32 + q) * ldq + d0 * 16 + hi * 8);
    const int kr0 = tid / KCH, kc0 = tid % KCH, kr1 = (tid + 512) / KCH, kc1 = (tid + 512) % KCH;
    const bool k1v = K2 && (tid + 512 < NKC);
    const unsigned kg0 = (unsigned)(kr0 * ldk + kc0 * 8) * 2u;
    const unsigned kg1 = (unsigned)((k1v ? kr1 : 0) * ldk + (k1v ? kc1 : 0) * 8) * 2u;
    const int vd = tid >> 3, vc = tid & 7;
    const unsigned vg = (unsigned)(vd * 2048 + vc * 8) * 2u;
    const int ks0 = kr0 * KP + kc0 * 16, ks1 = kr1 * KP + kc1 * 16, vs = 2 * KBUF + vd * VP + vc * 16;
    const int pq = (q & 0x13) | ((q & 4) << 1) | ((q & 8) >> 1);
    const int ka = pq * KP + hi * 16, va = 2 * KBUF + q * VP + hi * 16;
#define LOADK(R, tile) do { const char* kt_ = (const char*)(Kp + (size_t)(tile) * 64 * ldk); R##_k0 = *(const GASP v4u*)(kt_ + kg0); if (K2) { if (k1v) R##_k1 = *(const GASP v4u*)(kt_ + kg1); } } while (0)
#define LOADV(R, tile) do { R##_v = *(const GASP v4u*)((const char*)(Vtp + (tile) * 64) + vg); } while (0)
#define STOREK(R, buf) do { *(LAS v4u*)(lds + (buf) * KBUF + ks0) = R##_k0; if (K2) { if (k1v) *(LAS v4u*)(lds + (buf) * KBUF + ks1) = R##_k1; } } while (0)
#define STOREV(R, buf) do { *(LAS v4u*)(lds + (buf) * VBUF + vs) = R##_v; } while (0)
#define QKT(S0, S1, buf, C0, C1) do { const LAS unsigned char* Kb_ = lds + (buf) * KBUF + ka; \
        _Pragma("unroll") for (int d0 = 0; d0 < ND; ++d0) { \
            const bf16x8 a0_ = *(const LAS bf16x8*)(Kb_ + d0 * 32), a1_ = *(const LAS bf16x8*)(Kb_ + 32 * KP + d0 * 32); \
            S0 = __builtin_amdgcn_mfma_f32_32x32x16_bf16(a0_, qf[d0], d0 == 0 ? C0 : S0, 0, 0, 0); \
            S1 = __builtin_amdgcn_mfma_f32_32x32x16_bf16(a1_, qf[d0], d0 == 0 ? C1 : S1, 0, 0, 0); } } while (0)
#define PVT(buf) do { const LAS unsigned char* Vb_ = lds + (buf) * VBUF + va; \
        _Pragma("unroll") for (int jj = 0; jj < 4; ++jj) { \
            const bf16x8 v0_ = *(const LAS bf16x8*)(Vb_ + jj * 32), v1_ = *(const LAS bf16x8*)(Vb_ + 32 * VP + jj * 32); \
            const bf16x8 pf_ = __builtin_bit_cast(bf16x8, pw[jj]); \
            o0 = __builtin_amdgcn_mfma_f32_32x32x16_bf16(v0_, pf_, o0, 0, 0, 0); \
            o1 = __builtin_amdgcn_mfma_f32_32x32x16_bf16(v1_, pf_, o1, 0, 0, 0); } } while (0)
    v4u a_k0, a_k1 = (v4u){0u, 0u, 0u, 0u}, a_v, b_k0, b_k1 = (v4u){0u, 0u, 0u, 0u}, b_v;
    LOADK(a, 0); LOADK(b, 1); LOADV(a, 0);
    STOREK(a, 0); STOREK(b, 1); STOREV(a, 1);
    LOADK(a, 2); LOADK(b, 3); LOADV(b, 1);
    ATT_BAR();
    f32x16 zero16, sc0, sc1, sn0, sn1, o0, o1, negm;
#pragma unroll
    for (int r = 0; r < 16; ++r) { zero16[r] = 0.f; o0[r] = 0.f; o1[r] = 0.f; }
    QKT(sc0, sc1, 0, zero16, zero16);
    float l_run = 0.f;
    {
        float mx = fmaxf(sc0[0], sc1[0]);
#pragma unroll
        for (int r = 1; r < 16; ++r) mx = fmaxf(mx, fmaxf(sc0[r], sc1[r]));
        mx = fmaxf(mx, __shfl_xor(mx, 32));
#pragma unroll
        for (int r = 0; r < 16; ++r) { sc0[r] -= mx; sc1[r] -= mx; negm[r] = -mx; }
    }
    v4u pw[4];
#pragma unroll
    for (int jj = 0; jj < 4; ++jj) pw[jj] = (v4u){0u, 0u, 0u, 0u};
#define FRAG_ADDR(i, BQ, BP) (((i) < 2 * ND) ? (lds + (BQ) * KBUF + ka + ((i) & 1) * 32 * KP + ((i) >> 1) * 32) \
                                             : (lds + (BP) * VBUF + va + (((i) - 2 * ND) & 1) * 32 * VP + (((i) - 2 * ND) >> 1) * 32))
#define SLICE(k, SC0, SC1, PW) do { \
        float e0_, e1_; \
        if ((k) < 8) { e0_ = __builtin_amdgcn_exp2f(SC0[2 * (k)]); e1_ = __builtin_amdgcn_exp2f(SC0[2 * (k) + 1]); } \
        else { e0_ = __builtin_amdgcn_exp2f(SC1[2 * (k) - 16]); e1_ = __builtin_amdgcn_exp2f(SC1[2 * (k) - 15]); } \
        lsA_ += e0_; lsB_ += e1_; \
        unsigned w_ = cvtpk(e0_, e1_); asm volatile("" : "+v"(w_), "+v"(lsA_), "+v"(lsB_)); PW[(k) >> 2][(k) & 3] = w_; \
    } while (0)
#define STAGE(t, R, BQ, BP, BS, PR, PW, SC0, SC1, SN0, SN1) do { \
        constexpr int NQ_ = 2 * ND, NM_ = NQ_ + 8; \
        constexpr int FD_ = 3, FR_ = FD_ + 1, SL0_ = 3;     \
        bf16x8 fr_[FR_]; \
        _Pragma("unroll") for (int i = 0; i < FD_; ++i) fr_[i] = *(const LAS bf16x8*)FRAG_ADDR(i, BQ, BP); \
        float lsA_ = 0.f, lsB_ = 0.f, mx_ = -INFINITY; \
        _Pragma("unroll") for (int k = 0; k < SL0_; ++k) { SLICE(k, SC0, SC1, PW); } \
        __builtin_amdgcn_sched_barrier(0); \
        _Pragma("unroll") for (int i = 0; i < NM_; ++i) { \
            if (i + FD_ < NM_) fr_[(i + FD_) % FR_] = *(const LAS bf16x8*)FRAG_ADDR(i + FD_, BQ, BP); \
            if (i < NQ_) { \
                const int d0_ = i >> 1; \
                if ((i & 1) == 0) SN0 = __builtin_amdgcn_mfma_f32_32x32x16_bf16(fr_[i % FR_], qf[d0_], d0_ == 0 ? negm : SN0, 0, 0, 0); \
                else              SN1 = __builtin_amdgcn_mfma_f32_32x32x16_bf16(fr_[i % FR_], qf[d0_], d0_ == 0 ? negm : SN1, 0, 0, 0); \
            } else { \
                const int j_ = i - NQ_; const bf16x8 pf_ = __builtin_bit_cast(bf16x8, PR[j_ >> 1]); \
                if ((j_ & 1) == 0) o0 = __builtin_amdgcn_mfma_f32_32x32x16_bf16(fr_[i % FR_], pf_, o0, 0, 0, 0); \
                else               o1 = __builtin_amdgcn_mfma_f32_32x32x16_bf16(fr_[i % FR_], pf_, o1, 0, 0, 0); \
            } \
            if (i + SL0_ < 16) { SLICE(i + SL0_, SC0, SC1, PW); }                  \
            if (i >= NM_ - 6) { \
                _Pragma("unroll") for (int r = 3 * (i - (NM_ - 6)); r < 3 * (i - (NM_ - 6)) + 3; ++r) if (r < 16) mx_ = fmaxf(fmaxf(mx_, SN0[r]), SN1[r]); \
                asm volatile("" : "+v"(mx_)); \
            } \
            if (i == 13) { STOREK(R, BS); }                    \
            if (i == 14) { STOREV(R, BS); } \
            if (i == 15) { const int tk_ = ((t) + 4 < NT) ? (t) + 4 : NT - 1, tv_ = ((t) + 2 < NT) ? (t) + 2 : NT - 1; LOADK(R, tk_); LOADV(R, tv_); } \
            __builtin_amdgcn_sched_barrier(0); \
        } \
        l_run = l_run * al_pend + (lsA_ + lsB_); \
        ATT_BAR(); \
        if (pend) { _Pragma("unroll") for (int r = 0; r < 16; ++r) { o0[r] *= al_pend; o1[r] *= al_pend; } } \
        pend = false; al_pend = 1.0f; \
        if (__any(mx_ > THR)) { \
            const float rm_ = fmaxf(mx_, __shfl_xor(mx_, 32)); \
            const float dl_ = fmaxf(rm_, 0.f); \
            al_pend = __builtin_amdgcn_exp2f(-dl_); pend = true; \
            _Pragma("unroll") for (int r = 0; r < 16; ++r) { SN0[r] -= dl_; SN1[r] -= dl_; negm[r] -= dl_; } \
        } \
    } while (0)
    float al_pend = 1.0f; bool pend = false;
    v4u pw2[4];
    for (int t = 0; t < NT; t += 2) {
        STAGE(t, a, 1, 1, 0, pw, pw2, sc0, sc1, sn0, sn1);
        STAGE(t + 1, b, 0, 0, 1, pw2, pw, sn0, sn1, sc0, sc1);
    }
#undef FRAG_ADDR
#undef SLICE
    PVT(1);
    l_run += __shfl_xor(l_run, 32);
    const float inv = __builtin_amdgcn_rcpf(l_run);
    bf16* orow = Op + (size_t)(wave * 32 + q) * 512 + 4 * hi;
#pragma unroll
    for (int a = 0; a < 4; ++a) {
        v2u w0, w1;
        w0.x = cvtpk(o0[4 * a] * inv, o0[4 * a + 1] * inv); w0.y = cvtpk(o0[4 * a + 2] * inv, o0[4 * a + 3] * inv);
        w1.x = cvtpk(o1[4 * a] * inv, o1[4 * a + 1] * inv); w1.y = cvtpk(o1[4 * a + 2] * inv, o1[4 * a + 3] * inv);
        *(GASP v2u*)(orow + 8 * a) = w0; *(GASP v2u*)(orow + 32 + 8 * a) = w1;
    }
    ATT_BAR();
#undef LOADK
#undef LOADV
#undef STOREK
#undef STOREV
#undef QKT
#undef PVT
#undef STAGE
}

__device__ __forceinline__ void attn_phase(Frame& F, unsigned char* ws) {
    const bf16* QM = (const bf16*)(ws + WS_QM); const bf16* KM = (const bf16*)(ws + WS_KM); const bf16* VTM = (const bf16*)(ws + WS_VTM); bf16* OM = (bf16*)(ws + WS_OM);
    const bf16* QG = (const bf16*)(ws + WS_QG); const bf16* KG = (const bf16*)(ws + WS_KG); const bf16* VTG = (const bf16*)(ws + WS_VTG); bf16* OG = (bf16*)(ws + WS_OG);
    constexpr int NU = 16 * 8 * 8;
    for (int lu = F.xr; lu < 256; lu += F.nx) {
        const int U = (lu < 128) ? (2 * F.xid) * 64 + lu : NU + (2 * F.xid) * 64 + (lu - 128);
        int tid_ = F.tid; asm volatile("" : "+v"(tid_));
        const int lane_ = tid_ & 63, wave_ = __builtin_amdgcn_readfirstlane(tid_ >> 6);
        if (U < NU) {
            const int qb = U & 7, h = (U >> 3) & 7, bl = U >> 6;
            const size_t r0 = (size_t)bl * 2048;
            attn_unit<96>(F.lds, QM + (r0 + qb * 256) * 768 + h * 96, 768, KM + r0 * 768 + h * 96, 768, VTM + (size_t)((bl * 8 + h) * 64) * 2048, OM + (r0 + qb * 256) * 512 + h * 64, tid_, lane_, wave_);
        } else {
            const int u = U - NU, qb = u & 7, hq = (u >> 3) & 7, bl = u >> 6, kvh = hq >> 2;
            const size_t r0 = (size_t)bl * 2048;
            attn_unit<64>(F.lds, QG + (r0 + qb * 256) * 512 + hq * 64, 512, KG + r0 * 128 + kvh * 64, 128, VTG + (size_t)((bl * 2 + kvh) * 64) * 2048, OG + (r0 + qb * 256) * 512 + hq * 64, tid_, lane_, wave_);
        }
    }
}

typedef __attribute__((address_space(1))) unsigned gu32;
#define XB_TMO      128
#define XB_XCNT(j)  (256  + 64 * (j))
#define XB_XSUB(j)  (1280 + 64 * (j))
#define XB_XGEN(j)  (2304 + 64 * (j))
#define XB_TOP      3328
#define XB_TOPGEN   3392
#define XCD_BAR_WORDS 3456
#define XB_SPIN_CAP (1u << 18)

__device__ __forceinline__ unsigned xb_ld(unsigned* p)              { return __hip_atomic_load(p, __ATOMIC_RELAXED, __HIP_MEMORY_SCOPE_AGENT); }
__device__ __forceinline__ unsigned xb_add(unsigned* p, unsigned v) { return __hip_atomic_fetch_add(p, v, __ATOMIC_RELAXED, __HIP_MEMORY_SCOPE_AGENT); }
__device__ __forceinline__ unsigned xb_xcc_id() { return (unsigned)__builtin_amdgcn_s_getreg((3 << 11) | 20) & 0xFu; }
#define XB_SPIN(cond, bar) do { unsigned _sp = 0; while (cond) { __builtin_amdgcn_s_sleep(1); \
    if ((++_sp & 255u) == 0u) { if (xb_ld(&(bar)[XB_TMO])) break; if (_sp > XB_SPIN_CAP) { atomicAdd(&(bar)[XB_TMO], 1u); break; } } } } while (0)

struct XcdBarrier {
    unsigned* bar; unsigned x;
    volatile LAS unsigned* st;
};

__device__ __forceinline__ XcdBarrier xcd_barrier_post(unsigned* bar, volatile LAS unsigned* st) {
    XcdBarrier b; b.bar = bar; b.x = xb_xcc_id(); b.st = st;
    if (threadIdx.x == 0) (void)xb_add(&bar[XB_XCNT(b.x)], 1u);
    return b;
}
__device__ __forceinline__ void xcd_barrier_complete(unsigned* bar, unsigned x, unsigned& nloc, unsigned& nx) {
    const unsigned G = gridDim.x * gridDim.y * gridDim.z;
    unsigned sum, cnt, mine, sp = 0u;
    for (;;) {
        sum = 0u; cnt = 0u; mine = 0u;
#pragma unroll
        for (unsigned j = 0; j < 16; ++j) { const unsigned c = xb_ld(&bar[XB_XCNT(j)]); sum += c; cnt += (c > 0u) ? 1u : 0u; mine = (j == x) ? c : mine; }
        if (sum == G) break;
        __builtin_amdgcn_s_sleep(1);
        if ((++sp & 255u) == 0u) { if (xb_ld(&bar[XB_TMO])) break; if (sp > XB_SPIN_CAP) { atomicAdd(&bar[XB_TMO], 1u); break; } }
    }
    nloc = mine > 0u ? mine : 1u; nx = cnt > 0u ? cnt : 1u;
}

__device__ __forceinline__ void xcd_barrier(const XcdBarrier& b) {
    asm volatile("s_waitcnt vmcnt(0)" ::: "memory");
    __syncthreads();
    if (threadIdx.x == 0) {
        unsigned* bar = b.bar;
        __builtin_amdgcn_s_waitcnt(0);
        unsigned nloc = b.st[0], nx = b.st[1];
        if (nloc == 0u) { xcd_barrier_complete(bar, b.x, nloc, nx); b.st[0] = nloc; b.st[1] = nx; }
        const unsigned old = xb_add(&bar[XB_XSUB(b.x)], 1u);
        const unsigned gen = old / nloc;
        if (old + 1u == (gen + 1u) * nloc) {
            __builtin_amdgcn_fence(__ATOMIC_RELEASE, "agent");
            asm volatile("s_waitcnt vmcnt(0)" ::: "memory");
            const unsigned og = xb_add(&bar[XB_TOP], 1u);
            const unsigned tg = og / nx;
            if (og + 1u == (tg + 1u) * nx) xb_add(&bar[XB_TOPGEN], 1u);
            else XB_SPIN(xb_ld(&bar[XB_TOPGEN]) == tg, bar);
            __builtin_amdgcn_fence(__ATOMIC_ACQUIRE, "agent");
            xb_add(&bar[XB_XGEN(b.x)], 1u);
            asm volatile("s_waitcnt vmcnt(0)" ::: "memory");
        } else {
            XB_SPIN(xb_ld(&bar[XB_XGEN(b.x)]) == gen, bar);
            __builtin_amdgcn_fence(__ATOMIC_ACQUIRE, "agent");
            asm volatile("s_waitcnt vmcnt(0)" ::: "memory");
        }
    }
    __syncthreads();
}

#define LB_SUB(j) (XCD_BAR_WORDS + 64 * (j))
#define LB_GEN(j) (XCD_BAR_WORDS + 512 + 64 * (j))
__device__ __forceinline__ void xcd_local_barrier(unsigned* bar, unsigned x, unsigned nx) {
    asm volatile("s_waitcnt vmcnt(0)" ::: "memory");
    __syncthreads();
    if (threadIdx.x == 0) {
        const unsigned old = xb_add(&bar[LB_SUB(x)], 1u);
        const unsigned gen = old / nx;
        if (old + 1u == (gen + 1u) * nx) xb_add(&bar[LB_GEN(x)], 1u);
        else XB_SPIN(xb_ld(&bar[LB_GEN(x)]) == gen, bar);
        __builtin_amdgcn_fence(__ATOMIC_ACQUIRE, "agent");
        asm volatile("s_waitcnt vmcnt(0)" ::: "memory");
    }
    __syncthreads();
}

template <class Epi>
__device__ __forceinline__ void run_gemm(Frame& F, const bf16* A, int lda, const bf16* Bt, int pm0, int LP, int N, int K, const Epi& E, int rev = 0) {
    pg8::Gemm g{A, Bt, TOK, N, K, lda}; pg8::XcdOrder S; S.init(pm0, LP, N, F.xr, F.nx, rev);
    pg8::gemm_phase<Epi, pg8::XcdOrder, true, true>(F.lds, g, S, E, F.tid);
}

constexpr int STEPS_PER_LAYER = 21, NSTEPS = 1 + DEPTH * STEPS_PER_LAYER;

__global__ void __launch_bounds__(NTHR, 2) fwd_megakernel(Args args) {
    extern __shared__ __attribute__((aligned(16))) unsigned char lds_raw[];
    cg::grid_group grid = cg::this_grid();
    const Args* ap = (const Args*)__builtin_amdgcn_kernarg_segment_ptr();
    volatile LAS unsigned* bst = (volatile LAS unsigned*)((LAS unsigned char*)lds_raw + 131072 + 64);
    if (threadIdx.x < 8) bst[threadIdx.x] = 0u;
    __syncthreads();
    for (int step = 0; step < NSTEPS; ++step) {
        asm volatile("" : "+s"(ap));
        const Args& args_ = *ap;
        Frame F;
        F.lds = (LAS unsigned char*)lds_raw;
        { int t_ = threadIdx.x; asm volatile("" : "+v"(t_)); F.tid = t_; }
        F.lane = F.tid & 63; F.wave = __builtin_amdgcn_readfirstlane(F.tid >> 6);
        { int b_ = blockIdx.x, g_ = gridDim.x; asm volatile("" : "+s"(b_), "+s"(g_)); F.bx = b_; F.G = g_; }
        F.vcu = (F.G % 8 == 0) ? (F.bx % 8) * (F.G / 8) + F.bx / 8 : F.bx;
        const bool local_ok = __builtin_amdgcn_readfirstlane(bst[4]) != 0u;
        if (local_ok) { F.xid = __builtin_amdgcn_readfirstlane(bst[2]); F.xr = __builtin_amdgcn_readfirstlane(bst[3]); F.nx = __builtin_amdgcn_readfirstlane(bst[0]); }
        else { F.xid = F.bx % 8; F.xr = F.bx / 8; F.nx = (F.G - F.xid + 7) / 8; }
        unsigned char* ws = uni(args_.ws);
        float* out = uni(args_.out);
        bool chip_wide = false;
        if (step == 0) {
            if (F.bx == 0) for (int i = F.tid; i < XCD_BAR_WORDS + 1024; i += NTHR) ((unsigned*)(ws + WS_BAR))[i] = 0u;
            p0_prologue(F, args_, ws);
        } else {
            const int sidx = step - 1, l = sidx / STEPS_PER_LAYER, ps = sidx % STEPS_PER_LAYER;
            int kind, hf = 0;
            if (ps < 4) kind = ps; else if (ps < 18) { hf = (ps - 4) / 7; kind = 4 + (ps - 4) % 7; } else kind = 11 + (ps - 18);
            chip_wide = false;
            const float* modl = (const float*)(ws + WS_MOD) + (size_t)l * 32 * NMODC;
            const bf16* W = (const bf16*)(ws + WS_WT) + (size_t)l * LW;
#define U_ ((bf16*)(ws + WS_U))
#define HID_ ((bf16*)(ws + WS_HID))
            const size_t hlo = (size_t)4096 * F.xid, fro = hlo + (size_t)4096 * hf;
            unsigned char* arena = ws + WS_X + (size_t)F.xid * ARENA;
            bf16* Gh = (bf16*)(arena + AR_G) - hlo * 2048; bf16* ZGh = (bf16*)(arena + AR_ZG) - hlo * 768; bf16* ZMh = (bf16*)(arena + AR_ZM) - hlo * 768;
            bf16* QRh = (bf16*)(arena + AR_QRAW) - hlo * 768; bf16* KVh = (bf16*)(arena + AR_KVRAW) - hlo * 1024;
            const int pmF = 32 * F.xid, pmH = 32 * F.xid + 16 * hf;
            if (kind == 0 || kind == 3 || kind == 11) {
                const bool fromx = (kind == 0 && l == 0);
                const void* hin = fromx ? (const void*)uni(args_.in[0]) : (const void*)(ws + WS_H);
                const float* gain = (kind == 0 ? uni(args_.in[4]) : kind == 3 ? uni(args_.in[7]) : uni(args_.in[20])) + l * DM;
                const int mi = (kind == 0) ? 0 : (kind == 3) ? 3 : 6;
                norm_phase(F, hin, fromx ? 0 : 1, gain, modl + mi * DM, modl + (mi + 1) * DM, U_);
            } else if (kind == 1 || kind == 12) {
                pg8::EpiB<0> E{HID_, FF, nullptr, nullptr, nullptr, nullptr, 0};
                run_gemm(F, U_, DM, W + (kind == 1 ? (size_t)0 : (size_t)14974976), pmF, 32, 2 * FF, DM, E);
            } else if (kind == 2 || kind == 10 || kind == 13) {
                if (kind == 10) {
                    bf16* hh = (bf16*)(ws + WS_H);
                    pg8::EpiRes E{hh, hh, modl + 5 * DM, 1.0f, 0, 1, 1};
                    run_gemm(F, (const bf16*)(ws + WS_MG) - fro * 1024, 1024, W + 13926400, pmH, 16, DM, DM, E);
                } else {
                    const bool fromx = (kind == 2 && l == 0), last = (kind == 13 && l == DEPTH - 1);
                    const void* hin = fromx ? (const void*)uni(args_.in[0]) : (const void*)(ws + WS_H);
                    void* hout = last ? (void*)out : (void*)(ws + WS_H);
                    pg8::EpiRes E{hin, hout, modl + (kind == 2 ? 2 : 8) * DM, 0.5f, 0, fromx ? 0 : 1, last ? 0 : 1};
                    run_gemm(F, HID_, FF, W + (kind == 2 ? (size_t)5767168 : (size_t)20742144), pmF, 32, DM, FF, E, 1);
                }
            } else if (kind == 4) {
                pg8::EpiB<1> E{Gh - fro * 2048, 2048, ZGh - fro * 768, ZMh - fro * 768, nullptr, nullptr, 0};
                run_gemm(F, U_, DM, W + 8650752, pmH, 16, 3584, DM, E);
            } else if (kind == 5) {
                pp1_phase(F, ws, ZGh, ZMh, uni(args_.in[15]) + l * 64, uni(args_.in[16]) + l * 64);
            } else if (kind == 6) {
                for (int w = 0; w < 2; ++w) {
                    pg8::EpiB<2> E{(w == 0 ? QRh - fro * 768 : KVh - fro * 1024), w == 0 ? 768 : 1024, nullptr, nullptr, nullptr, (const float*)(ws + (w == 0 ? WS_RSQ : WS_RSKV)) - fro, 0};
                    run_gemm(F, ZMh - fro * 768 + (w == 0 ? 0 : 384), 768, W + (w == 0 ? (size_t)12320768 : (size_t)12615680), pmH, 16, w == 0 ? 768 : 1024, w == 0 ? 384 : 256, E);
                }
            } else if (kind == 7) {
                pp2_phase(F, ws, QRh, KVh, ZMh, uni(args_.in[13]) + l * 96, uni(args_.in[14]) + l * 96);
            } else if (kind == 8) {
                attn_phase(F, ws);
            } else if (kind == 9) {
                for (int w = 0; w < 2; ++w) {
                    pg8::EpiB<3> E{(bf16*)(ws + WS_MG) - fro * 1024, 1024, nullptr, nullptr, Gh - fro * 2048, nullptr, w};
                    run_gemm(F, (const bf16*)(ws + (w == 0 ? WS_OM : WS_OG)) - fro * 512, 512, W + (w == 0 ? (size_t)12877824 : (size_t)13402112), pmH, 16, DM, 512, E);
                }
            }
        }
        unsigned* barw = (unsigned*)(ws + WS_BAR);
        if (step == 0) {
            grid.sync();
            if (threadIdx.x == 0) { const unsigned x = xb_xcc_id(); bst[2] = x; bst[3] = xb_add(&barw[XB_XCNT(x)], 1u); }
            __syncthreads();
            XcdBarrier bar; bar.bar = barw; bar.x = xb_xcc_id(); bar.st = bst;
            xcd_barrier(bar);
            if (threadIdx.x == 0) {
                bool ok = true;
                for (unsigned j = 0; j < 16; ++j) { const unsigned c = xb_ld(&barw[XB_XCNT(j)]); ok = ok && ((j < 8) ? (c > 0u) : (c == 0u)); }
                bst[4] = (ok && xb_ld(&barw[XB_TMO]) == 0u) ? 1u : 0u;
            }
            __syncthreads();
        } else if (step + 1 < NSTEPS) {
            if (local_ok && !chip_wide) xcd_local_barrier(barw, (unsigned)F.xid, (unsigned)F.nx);
            else { XcdBarrier bar; bar.bar = barw; bar.x = xb_xcc_id(); bar.st = bst; xcd_barrier(bar); }
        }
    }
}

extern "C" void kernel_launch(void* const* d_in, const int* in_sizes, int n_in, void* d_out, int out_size, void* d_ws, size_t ws_size, hipStream_t stream) {
    static int grid = 0;
    if (grid == 0) {
        if (n_in != 23 || out_size != TOK * DM || ws_size < WS_END) { fprintf(stderr, "kernel_launch: unexpected shapes (n_in %d, out %d, ws %zu < %zu)\n", n_in, out_size, ws_size, (size_t)WS_END); grid = -1; return; }
        int dev = 0, cus = 0, per_cu = 0;
        hipGetDevice(&dev);
        hipDeviceGetAttribute(&cus, hipDeviceAttributeMultiprocessorCount, dev);
        hipFuncSetAttribute((const void*)fwd_megakernel, hipFuncAttributeMaxDynamicSharedMemorySize, LDS_BYTES);
        hipOccupancyMaxActiveBlocksPerMultiprocessor(&per_cu, (const void*)fwd_megakernel, NTHR, LDS_BYTES);
        if (per_cu < 1) per_cu = 1;
        grid = cus * per_cu;
        (void)hipGetLastError();
    }
    if (grid < 0) return;
    Args a{};
    for (int i = 0; i < 23; ++i) a.in[i] = (const float*)d_in[i];
    a.out = (float*)d_out; a.ws = (unsigned char*)d_ws;
    void* kargs[] = {&a};
    hipError_t e = hipLaunchCooperativeKernel((const void*)fwd_megakernel, dim3(grid), dim3(NTHR), kargs, LDS_BYTES, stream);
    if (e != hipSuccess) fprintf(stderr, "cooperative launch failed: %s (grid %d)\n", hipGetErrorString(e), grid);
}
```

```cpp
#include <hip/hip_runtime.h>
#include <hip/hip_cooperative_groups.h>
#include <cstdio>
#include <cstdint>
namespace cg = cooperative_groups;

namespace pg8 {
#define PG8_LAS __attribute__((address_space(3)))
#define PG8_GAS __attribute__((address_space(1)))
typedef unsigned short bf16_t;
typedef short bf16x8 __attribute__((ext_vector_type(8)));
typedef float f32x4 __attribute__((ext_vector_type(4)));
typedef unsigned u32x4 __attribute__((ext_vector_type(4)));
constexpr int BM = 256, BK = 64, HALF = 128, HTB = HALF * BK * 2  , STAGE_BYTES = 8 * HTB, NXCD = 8, WGM = 8;

__host__ __device__ __forceinline__ int lds_byte(int r, int c) { const int st = (r >> 4) * 2 + (c >> 5), rr = r & 15, cc = c & 31, ob = rr * 64 + cc * 2; return st * 1024 + (ob ^ (((ob >> 9) & 1) << 5)); }
__host__ __device__ __forceinline__ void stage_rc(int b, int& R, int& C) { const int st = b / 1024, sb = b % 1024, swz = sb ^ (((sb >> 9) & 1) << 5); R = (st >> 1) * 16 + swz / 64; C = (st & 1) * 32 + (swz % 64) / 2; }
__host__ __device__ __forceinline__ int perm32(int rho) { const int n = rho >> 4, i = rho & 15; return 8 * (i >> 2) + 4 * n + (i & 3); }

struct Unit { int pm, pn; };
struct Gemm { const bf16_t* A; const bf16_t* Bt; int M, N, K, lda; };

struct StaticOrder {
    int nM, nN, nwg, G, c, rev;
    __host__ __device__ void init(int M, int N, int G_, int c_, int rev_ = 0) { nM = M / BM; nN = N / BM; nwg = nM * nN; G = G_; c = c_; rev = rev_; }
    __host__ __device__ bool next(int i, Unit& u) const {
        const long L = (long)i * G + c; if (L >= nwg) return false;
        int wgid = rev ? (nwg - 1 - (int)L) : (int)L; { const int q = nwg / NXCD, r = nwg % NXCD, xcd = wgid % NXCD, off = wgid / NXCD; wgid = (xcd < r ? xcd * (q + 1) : r * (q + 1) + (xcd - r) * q) + off; }
        const int nig = WGM * nN, gid = wgid / nig, fm = gid * WGM, gsz = (nM - fm) < WGM ? (nM - fm) : WGM;
        u.pm = fm + ((wgid % nig) % gsz); u.pn = (wgid % nig) / gsz; return true;
    }
    __device__ __forceinline__ void a_ready(const Unit&) const {}
    __device__ __forceinline__ void done(const Unit&) const {}
};

struct XcdOrder {
    int nN, q, r, nx, rev, pm0;
    __device__ void init(int pm0_, int LP, int N, int r_, int nx_, int rev_) { nN = N / BM; q = LP * nN; pm0 = pm0_; r = r_; nx = nx_; rev = rev_; }
    __device__ bool next(int i, Unit& u) const {
        int off = i * nx + r; if (off >= q) return false;
        if (rev) off = q - 1 - off;
        const int nig = WGM * nN, gid = off / nig, rem = off % nig;
        u.pn = rem / WGM; u.pm = pm0 + gid * WGM + rem % WGM; return true;
    }
    __device__ __forceinline__ void a_ready(const Unit&) const {}
    __device__ __forceinline__ void done(const Unit&) const {}
};

typedef float f32x2_ __attribute__((ext_vector_type(2))); typedef __bf16 bf16x2_ __attribute__((ext_vector_type(2)));
__device__ __forceinline__ unsigned cvt_pk_bf16(float lo, float hi) { const f32x2_ v = {lo, hi}; const bf16x2_ b = __builtin_convertvector(v, bf16x2_); return __builtin_bit_cast(unsigned, b); }
__device__ __forceinline__ float bf_lo(unsigned w) { return __uint_as_float(w << 16); }
__device__ __forceinline__ float bf_hi(unsigned w) { return __uint_as_float(w & 0xffff0000u); }
__device__ __forceinline__ float sigmoidf_(float x) { return __builtin_amdgcn_rcpf(1.0f + __builtin_amdgcn_exp2f(x * -1.4426950408889634f)); }

template <int MODE> struct EpiB {
    static constexpr bool PERM = true, AFTER_DRAIN = false;
    bf16_t* O; int ldc; bf16_t* O2; bf16_t* O3; const bf16_t* Gt; const float* rs; int add;
    __device__ __forceinline__ void operator()(const f32x4 (&acc)[2][2][4][2], const Unit& u, int wr, int wc, int fr, int fq) const {
        const int row0 = u.pm * BM + wr * 64 + fr;
        if constexpr (MODE == 0) {
            const int col0 = u.pn * HALF + wc * 32 + 8 * fq;
#pragma unroll
            for (int ai = 0; ai < 2; ++ai)
#pragma unroll
                for (int m = 0; m < 4; ++m) {
                    bf16_t* rowp = O + (size_t)(row0 + ai * HALF + m * 16) * ldc + col0;
                    const f32x4 a0 = acc[ai][0][m][0], a1 = acc[ai][0][m][1], b0 = acc[ai][1][m][0], b1 = acc[ai][1][m][1];
                    const float av[8] = {a0[0], a0[1], a0[2], a0[3], a1[0], a1[1], a1[2], a1[3]}, bv[8] = {b0[0], b0[1], b0[2], b0[3], b1[0], b1[1], b1[2], b1[3]};
                    float e[8], o[8];
#pragma unroll
                    for (int j = 0; j < 8; ++j) e[j] = __builtin_amdgcn_exp2f(-av[j]);
#pragma unroll
                    for (int j = 0; j < 8; ++j) e[j] = 1.0f + e[j];
#pragma unroll
                    for (int j = 0; j < 8; ++j) e[j] = __builtin_amdgcn_rcpf(e[j]);
#pragma unroll
                    for (int j = 0; j < 8; ++j) o[j] = (av[j] * bv[j]) * e[j];
                    u32x4 w; w.x = cvt_pk_bf16(o[0], o[1]); w.y = cvt_pk_bf16(o[2], o[3]); w.z = cvt_pk_bf16(o[4], o[5]); w.w = cvt_pk_bf16(o[6], o[7]);
                    *(PG8_GAS u32x4*)rowp = w;
                }
        } else {
            bf16_t* base = O; int ld = ldc; int colt = u.pn * BM;
            if constexpr (MODE == 1) { if (u.pn >= 11) { base = O3; ld = 768; colt = (u.pn - 11) * BM; } else if (u.pn >= 8) { base = O2; ld = 768; colt = (u.pn - 8) * BM; } }
            const int col0 = colt + wc * 32 + 8 * fq;
#pragma unroll
            for (int ai = 0; ai < 2; ++ai) {
                float rsc[4]; u32x4 gg[4][2], qq[4][2];
#pragma unroll
                for (int m = 0; m < 4; ++m) {
                    const int row = row0 + ai * HALF + m * 16;
                    rsc[m] = 1.f; if constexpr (MODE == 2) rsc[m] = *(const PG8_GAS float*)(rs + row);
#pragma unroll
                    for (int bj = 0; bj < 2; ++bj) {
                        if constexpr (MODE == 3) {
                            gg[m][bj] = *(const PG8_GAS u32x4*)(Gt + (size_t)row * 2048 + (add ? 1024 : 0) + col0 + bj * HALF);
                            if (add) qq[m][bj] = *(const PG8_GAS u32x4*)(base + (size_t)row * ld + col0 + bj * HALF);
                        }
                    }
                }
                asm volatile("" ::: "memory");
#pragma unroll
                for (int m = 0; m < 4; ++m) {
                    const int row = row0 + ai * HALF + m * 16;
#pragma unroll
                    for (int bj = 0; bj < 2; ++bj) {
                        bf16_t* p = base + (size_t)row * ld + col0 + bj * HALF;
                        f32x4 v0 = acc[ai][bj][m][0], v1 = acc[ai][bj][m][1];
                        if constexpr (MODE == 2) { v0 = v0 * rsc[m]; v1 = v1 * rsc[m]; }
                        if constexpr (MODE == 3) {
                            const u32x4 g = gg[m][bj];
                            float e[8] = {bf_lo(g.x), bf_hi(g.x), bf_lo(g.y), bf_hi(g.y), bf_lo(g.z), bf_hi(g.z), bf_lo(g.w), bf_hi(g.w)};
#pragma unroll
                            for (int j = 0; j < 8; ++j) e[j] = __builtin_amdgcn_exp2f(-e[j]);
#pragma unroll
                            for (int j = 0; j < 8; ++j) e[j] = 1.0f + e[j];
#pragma unroll
                            for (int j = 0; j < 8; ++j) e[j] = __builtin_amdgcn_rcpf(e[j]);
                            v0[0] *= e[0]; v0[1] *= e[1]; v0[2] *= e[2]; v0[3] *= e[3]; v1[0] *= e[4]; v1[1] *= e[5]; v1[2] *= e[6]; v1[3] *= e[7];
                            if (add) {
                                const u32x4 q = qq[m][bj];
                                v0[0] += bf_lo(q.x); v0[1] += bf_hi(q.x); v0[2] += bf_lo(q.y); v0[3] += bf_hi(q.y);
                                v1[0] += bf_lo(q.z); v1[1] += bf_hi(q.z); v1[2] += bf_lo(q.w); v1[3] += bf_hi(q.w);
                            }
                        }
                        u32x4 w; w.x = cvt_pk_bf16(v0[0], v0[1]); w.y = cvt_pk_bf16(v0[2], v0[3]); w.z = cvt_pk_bf16(v1[0], v1[1]); w.w = cvt_pk_bf16(v1[2], v1[3]);
                        *(PG8_GAS u32x4*)p = w;
                    }
                }
                asm volatile("" ::: "memory");
            }
        }
    }
};
struct EpiRes {
    static constexpr bool PERM = false, AFTER_DRAIN = false;
    const void* base; void* out; const float* gate; float coef; int row_off; int in_bf, out_bf;
    __device__ __forceinline__ void operator()(const f32x4 (&acc)[2][2][4][2], const Unit& u, int wr, int wc, int fr, int fq) const {
        typedef unsigned u32x2 __attribute__((ext_vector_type(2)));
        const int b = (u.pm * BM + row_off) >> 11;
        const int col0 = u.pn * BM + wc * 32 + 4 * fq;
        f32x4 gv[2][2];
#pragma unroll
        for (int bj = 0; bj < 2; ++bj)
#pragma unroll
            for (int n = 0; n < 2; ++n) gv[bj][n] = *(const PG8_GAS f32x4*)(gate + (size_t)b * 9216 + col0 + bj * HALF + n * 16) * coef;
#pragma unroll
        for (int ai = 0; ai < 2; ++ai)
#pragma unroll
            for (int mh = 0; mh < 2; ++mh) {
                u32x4 raw[2][2][2];
#pragma unroll
                for (int mm = 0; mm < 2; ++mm) {
                    const size_t off = (size_t)(u.pm * BM + ai * HALF + wr * 64 + (2 * mh + mm) * 16 + fr) * 1024 + col0;
#pragma unroll
                    for (int bj = 0; bj < 2; ++bj)
#pragma unroll
                        for (int n = 0; n < 2; ++n) {
                            const size_t o = off + bj * HALF + n * 16;
                            if (in_bf) { const u32x2 w = *(const PG8_GAS u32x2*)((const bf16_t*)base + o); raw[mm][bj][n].x = w.x; raw[mm][bj][n].y = w.y; }
                            else raw[mm][bj][n] = *(const PG8_GAS u32x4*)((const float*)base + o);
                        }
                }
                asm volatile("" ::: "memory");
#pragma unroll
                for (int mm = 0; mm < 2; ++mm) {
                    const int m = 2 * mh + mm;
                    const size_t off = (size_t)(u.pm * BM + ai * HALF + wr * 64 + m * 16 + fr) * 1024 + col0;
#pragma unroll
                    for (int bj = 0; bj < 2; ++bj)
#pragma unroll
                        for (int n = 0; n < 2; ++n) {
                            const size_t o = off + bj * HALF + n * 16;
                            const u32x4 w4 = raw[mm][bj][n];
                            f32x4 bs;
                            if (in_bf) bs = (f32x4){bf_lo(w4.x), bf_hi(w4.x), bf_lo(w4.y), bf_hi(w4.y)};
                            else bs = (f32x4){__uint_as_float(w4.x), __uint_as_float(w4.y), __uint_as_float(w4.z), __uint_as_float(w4.w)};
                            const f32x4 r = bs + gv[bj][n] * acc[ai][bj][m][n];
                            if (out_bf) { u32x2 w; w.x = cvt_pk_bf16(r[0], r[1]); w.y = cvt_pk_bf16(r[2], r[3]); *(PG8_GAS u32x2*)((bf16_t*)out + o) = w; }
                            else *(PG8_GAS f32x4*)((float*)out + o) = r;
                        }
                }
                asm volatile("" ::: "memory");
            }
    }
};

template <class Epi, class Sched, bool ALIGN_EPI = false, bool SP2 = false>
__device__ __forceinline__ void gemm_phase(PG8_LAS unsigned char* lds, const Gemm g, const Sched& S, const Epi& E, const int tid) {
    const int wid = __builtin_amdgcn_readfirstlane(tid >> 6), lane = tid & 63, wr = wid >> 2, wc = wid & 3, fr = lane & 15, fq = lane >> 4;
    const int K = g.K, lda = g.lda, nt = K / BK;
    unsigned voffA[2], voffB[2];
#pragma unroll
    for (int i = 0; i < 2; ++i) { int R, C; stage_rc(tid * 16 + i * 8192, R, C); const int Rb = Epi::PERM ? ((R & ~31) + perm32(R & 31)) : R;
        voffA[i] = (unsigned)(R * lda + C) * 2u; voffB[i] = (unsigned)(Rb * K + C) * 2u; }
    const size_t kstep = (size_t)(BK * 2);
    const size_t hstepA = (size_t)HALF * lda * 2, hstepB = (size_t)HALF * K * 2;
    const size_t tstepA = 2 * hstepA, tstepB = 2 * hstepB;
    const unsigned ldsw = (unsigned)wid * 1024u;
    const int aoff = lds_byte(wr * 64 + fr, fq * 8), boff = lds_byte(wc * 32 + fr, fq * 8);
#define PG8_SA(b, h) (((b) * 2 + (h)) * HTB)
#define PG8_SB(b, h) ((4 + (b) * 2 + (h)) * HTB)
#define PG8_STAGE(bufoff, gbase, voff) do { _Pragma("unroll") for (int _i = 0; _i < 2; ++_i) \
        __builtin_amdgcn_global_load_lds((const unsigned*)((const char*)(gbase) + (voff)[_i]), (PG8_LAS unsigned*)(lds + (bufoff) + ldsw + _i * 8192), 16, 0, 0); } while (0)
#define PG8_LDA(dst, b, h) do { _Pragma("unroll") for (int m = 0; m < 4; ++m) _Pragma("unroll") for (int k = 0; k < 2; ++k) dst[m][k] = *(const PG8_LAS bf16x8*)(lds + PG8_SA(b, h) + aoff + m * 2048 + k * 1024); } while (0)
#define PG8_LDB(dst, b, h) do { _Pragma("unroll") for (int n = 0; n < 2; ++n) _Pragma("unroll") for (int k = 0; k < 2; ++k) dst[n][k] = *(const PG8_LAS bf16x8*)(lds + PG8_SB(b, h) + boff + n * 2048 + k * 1024); } while (0)
#define PG8_MMA(ai, bj, At, Bt) do { __builtin_amdgcn_s_setprio(1); _Pragma("unroll") for (int m = 0; m < 4; ++m) _Pragma("unroll") for (int n = 0; n < 2; ++n) _Pragma("unroll") for (int k = 0; k < 2; ++k) \
        acc[ai][bj][m][n] = __builtin_amdgcn_mfma_f32_16x16x32_bf16(Bt[n][k], At[m][k], acc[ai][bj][m][n], 0, 0, 0); __builtin_amdgcn_s_setprio(0); } while (0)
#define PG8_WAIT_V(n) asm volatile("s_waitcnt vmcnt(" #n ")" ::: "memory")
#define PG8_WAIT_L(n) asm volatile("s_waitcnt lgkmcnt(" #n ")" ::: "memory")
#define PG8_BAR __builtin_amdgcn_s_barrier()
#define PG8_SCHED __builtin_amdgcn_sched_barrier(0)
    Unit cur, nxt; int ui = 0;
    if (!S.next(0, cur)) return;
    f32x4 acc[2][2][4][2];
#pragma unroll
    for (int a = 0; a < 2; ++a)
#pragma unroll
        for (int b = 0; b < 2; ++b)
#pragma unroll
            for (int m = 0; m < 4; ++m)
#pragma unroll
                for (int n = 0; n < 2; ++n) acc[a][b][m][n] = (f32x4){0.f, 0.f, 0.f, 0.f};
    bf16x8 At[4][2], B0[2][2], B1[2][2];
    const char* cA = (const char*)g.A + (size_t)cur.pm * tstepA; const char* cB = (const char*)g.Bt + (size_t)cur.pn * tstepB;
    S.a_ready(cur);
    if constexpr (SP2) {
        PG8_STAGE(PG8_SB(0, 0), cB, voffB); PG8_STAGE(PG8_SB(0, 1), cB + hstepB, voffB); PG8_STAGE(PG8_SA(0, 0), cA, voffA); PG8_STAGE(PG8_SA(0, 1), cA + hstepA, voffA);
        if (wr == 1) PG8_BAR;
        PG8_WAIT_V(2); PG8_BAR;
        PG8_STAGE(PG8_SB(1, 0), cB + kstep, voffB); PG8_STAGE(PG8_SA(1, 0), cA + kstep, voffA); PG8_STAGE(PG8_SB(1, 1), cB + hstepB + kstep, voffB);
        PG8_WAIT_V(6); PG8_BAR;
    } else {
        PG8_STAGE(PG8_SB(0, 0), cB, voffB); PG8_STAGE(PG8_SA(0, 0), cA, voffA); PG8_STAGE(PG8_SB(0, 1), cB + hstepB, voffB); PG8_STAGE(PG8_SA(0, 1), cA + hstepA, voffA);
        if (wr == 1) PG8_BAR;
        PG8_WAIT_V(4); PG8_BAR;
        PG8_STAGE(PG8_SB(1, 0), cB + kstep, voffB); PG8_STAGE(PG8_SA(1, 0), cA + kstep, voffA); PG8_STAGE(PG8_SB(1, 1), cB + hstepB + kstep, voffB);
        PG8_WAIT_V(6); PG8_BAR;
    }
    for (;;) {
        const bool has_next = S.next(ui + 1, nxt);
        const char* nA = has_next ? (const char*)g.A + (size_t)nxt.pm * tstepA : cA; const char* nB = has_next ? (const char*)g.Bt + (size_t)nxt.pn * tstepB : cB;
        for (int t = 0; t < nt; t += 2) {
            const bool last = (t == nt - 2);
            const char* a1 = cA + (size_t)(t + 1) * kstep;
            const char* a2 = last ? nA : cA + (size_t)(t + 2) * kstep; const char* b2 = last ? nB : cB + (size_t)(t + 2) * kstep;
            const char* a3 = a2 + kstep; const char* b3 = b2 + kstep;
            if (last && has_next) S.a_ready(nxt);
            if constexpr (SP2) {
            PG8_LDB(B0, 0, 0); PG8_LDB(B1, 0, 1); PG8_SCHED; PG8_LDA(At, 0, 0); PG8_STAGE(PG8_SA(1, 1), a1 + hstepA, voffA);
            PG8_WAIT_V(8); PG8_WAIT_L(0); PG8_BAR; PG8_MMA(0, 0, At, B0); PG8_MMA(0, 1, At, B1); PG8_BAR; PG8_SCHED;
            PG8_LDA(At, 0, 1); PG8_STAGE(PG8_SB(0, 0), b2, voffB); PG8_STAGE(PG8_SB(0, 1), b2 + hstepB, voffB); PG8_STAGE(PG8_SA(0, 0), a2, voffA);
            PG8_WAIT_V(8); PG8_WAIT_L(0); PG8_BAR; PG8_MMA(1, 0, At, B0); PG8_MMA(1, 1, At, B1); PG8_BAR; PG8_SCHED;
            PG8_LDB(B0, 1, 0); PG8_LDB(B1, 1, 1); PG8_SCHED; PG8_LDA(At, 1, 0); PG8_STAGE(PG8_SA(0, 1), a2 + hstepA, voffA);
            PG8_WAIT_V(8); PG8_WAIT_L(0); PG8_BAR; PG8_MMA(0, 0, At, B0); PG8_MMA(0, 1, At, B1); PG8_BAR; PG8_SCHED;
            PG8_LDA(At, 1, 1); PG8_STAGE(PG8_SB(1, 0), b3, voffB); PG8_STAGE(PG8_SB(1, 1), b3 + hstepB, voffB); PG8_STAGE(PG8_SA(1, 0), a3, voffA);
            PG8_WAIT_V(8); PG8_WAIT_L(0); PG8_BAR; PG8_MMA(1, 0, At, B0); PG8_MMA(1, 1, At, B1); PG8_BAR; PG8_SCHED;
            } else {
            PG8_LDB(B0, 0, 0); PG8_SCHED; PG8_LDA(At, 0, 0); PG8_STAGE(PG8_SA(1, 1), a1 + hstepA, voffA);
            PG8_WAIT_L(8); PG8_BAR; PG8_WAIT_L(0); PG8_MMA(0, 0, At, B0); PG8_BAR; PG8_SCHED;
            PG8_LDB(B1, 0, 1); PG8_STAGE(PG8_SB(0, 0), b2, voffB);
            PG8_BAR; PG8_WAIT_L(0); PG8_MMA(0, 1, At, B1); PG8_BAR;
            PG8_LDA(At, 0, 1); PG8_STAGE(PG8_SA(0, 0), a2, voffA);
            PG8_BAR; PG8_WAIT_L(0); PG8_MMA(1, 0, At, B0); PG8_BAR; PG8_SCHED;
            PG8_STAGE(PG8_SB(0, 1), b2 + hstepB, voffB);
            PG8_WAIT_V(6); PG8_BAR; PG8_MMA(1, 1, At, B1); PG8_BAR;
            PG8_LDB(B0, 1, 0); PG8_SCHED; PG8_LDA(At, 1, 0); PG8_STAGE(PG8_SA(0, 1), a2 + hstepA, voffA);
            PG8_WAIT_L(8); PG8_BAR; PG8_WAIT_L(0); PG8_MMA(0, 0, At, B0); PG8_BAR; PG8_SCHED;
            PG8_LDB(B1, 1, 1); PG8_STAGE(PG8_SB(1, 0), b3, voffB);
            PG8_BAR; PG8_WAIT_L(0); PG8_MMA(0, 1, At, B1); PG8_BAR;
            PG8_LDA(At, 1, 1); PG8_STAGE(PG8_SA(1, 0), a3, voffA);
            PG8_BAR; PG8_WAIT_L(0); PG8_MMA(1, 0, At, B0); PG8_BAR; PG8_SCHED;
            PG8_STAGE(PG8_SB(1, 1), b3 + hstepB, voffB);
            PG8_WAIT_V(6); PG8_BAR; PG8_MMA(1, 1, At, B1); PG8_BAR;
            }
        }
        if constexpr (ALIGN_EPI) { if (wr == 0) PG8_BAR; }
        if constexpr (!Epi::AFTER_DRAIN) { E(acc, cur, wr, wc, fr, fq); S.done(cur); }
        if (!has_next) break;
#pragma unroll
        for (int a = 0; a < 2; ++a)
#pragma unroll
            for (int b = 0; b < 2; ++b)
#pragma unroll
                for (int m = 0; m < 4; ++m)
#pragma unroll
                    for (int n = 0; n < 2; ++n) acc[a][b][m][n] = (f32x4){0.f, 0.f, 0.f, 0.f};
        cur = nxt; cA = nA; cB = nB; ++ui;
        if constexpr (ALIGN_EPI) { if (wr == 1) PG8_BAR; }
    }
    PG8_WAIT_V(0);
    if constexpr (!ALIGN_EPI) { if (wr == 0) PG8_BAR; }
    PG8_BAR;
    if constexpr (Epi::AFTER_DRAIN) { E.fused(acc, cur, wr, wc, fr, fq, lds, wid, lane); S.done(cur); }
#undef PG8_SA
#undef PG8_SB
#undef PG8_STAGE
#undef PG8_LDA
#undef PG8_LDB
#undef PG8_MMA
#undef PG8_WAIT_V
#undef PG8_WAIT_L
#undef PG8_BAR
#undef PG8_SCHED
}
}

#define LAS __attribute__((address_space(3)))
#define GASP __attribute__((address_space(1)))
typedef unsigned short bf16;
typedef unsigned v4u __attribute__((ext_vector_type(4)));
typedef unsigned v2u __attribute__((ext_vector_type(2)));
typedef float f32x2 __attribute__((ext_vector_type(2)));
typedef float f32x4 __attribute__((ext_vector_type(4)));
typedef float f32x16 __attribute__((ext_vector_type(16)));
typedef short bf16x8 __attribute__((ext_vector_type(8)));

constexpr int NWAVES = 8, NTHR = 512;
constexpr int BATCH = 32, SEQ = 2048, DM = 1024, DEPTH = 2, TOK = BATCH * SEQ, FF = 2816, NMODC = 9216;
constexpr int TH = TOK / 2;
constexpr float EPS = 1e-6f;
constexpr float QS_G = 0.125f * 1.4426950408889634f;
constexpr float QS_M = 0.10206207261596575f * 1.4426950408889634f;
constexpr int LDS_BYTES = 147456;

constexpr size_t MiB = 1u << 20;
constexpr size_t WS_MOD = 0, WS_CS = 3 * MiB, WS_RSQ = WS_CS + 262144, WS_RSKV = WS_RSQ + 131072;
constexpr size_t WS_BAR = WS_RSKV + 131072;
constexpr size_t WS_WT = 4 * MiB, WS_U = 100 * MiB, WS_X = 228 * MiB;
constexpr size_t WS_HID = WS_X;
constexpr size_t ARENA = (size_t)8192 * FF * 2, AR_G = 0, AR_ZG = 16 * MiB, AR_ZM = 22 * MiB, AR_QRAW = 28 * MiB, AR_KVRAW = 34 * MiB;
static_assert(AR_KVRAW + (size_t)4096 * 1024 * 2 <= ARENA && 8 * ARENA == (size_t)TOK * FF * 2, "arena map");
constexpr size_t WS_Y = 580 * MiB;
constexpr size_t WS_QG = WS_Y, WS_KG = WS_Y + 32 * MiB, WS_VTG = WS_Y + 40 * MiB, WS_QM = WS_Y + 48 * MiB, WS_KM = WS_Y + 96 * MiB, WS_VTM = WS_Y + 144 * MiB,
                 WS_OM = WS_Y + 176 * MiB, WS_OG = WS_Y + 208 * MiB, WS_MG = WS_Y + 240 * MiB, WS_H = WS_Y + 304 * MiB  , WS_END = WS_Y + 432 * MiB;
static_assert(WS_HID + (size_t)TOK * FF * 2 <= WS_Y, "ws map");
constexpr size_t LW = 23625728;
static_assert(WS_WT + 2 * LW * 2 <= WS_U, "weights fit");

struct Frame {
    LAS unsigned char* lds;
    int tid, lane, wave, vcu, G, bx;
    int xid, xr, nx;
};

__device__ __forceinline__ float wave_sum(float v) {
#pragma unroll
    for (int o = 1; o < 64; o <<= 1) v += __shfl_xor(v, o);
    return v;
}
template <class T> __device__ __forceinline__ T* uni(T* p) {
    const unsigned long long v = (unsigned long long)p;
    const unsigned lo = __builtin_amdgcn_readfirstlane((unsigned)v), hi = __builtin_amdgcn_readfirstlane((unsigned)(v >> 32));
    return (T*)(((unsigned long long)hi << 32) | lo);
}
__device__ __forceinline__ float bf2f(bf16 v) { return __uint_as_float((unsigned)v << 16); }
__device__ __forceinline__ unsigned f2bf(float f) { unsigned u = __float_as_uint(f); return (u + 0x7fffu + ((u >> 16) & 1u)) >> 16; }
__device__ __forceinline__ unsigned pk2(float lo, float hi) { return f2bf(lo) | (f2bf(hi) << 16); }

__device__ __forceinline__ void mat_info(int mat, int& K, int& Nd, int& Ns, size_t& off, int& in_idx, int& gain_idx) {
    gain_idx = -1;
    switch (mat) {
        case 0: K = 1024; Nd = 5632; Ns = 5632; off = 0; in_idx = 5; break;
        case 1: K = 2816; Nd = 1024; Ns = 1024; off = 5767168; in_idx = 6; break;
        case 2: K = 1024; Nd = 3584; Ns = 3488; off = 8650752; in_idx = 8; break;
        case 3: K = 384; Nd = 768; Ns = 768; off = 12320768; in_idx = 10; gain_idx = 9; break;
        case 4: K = 256; Nd = 1024; Ns = 1024; off = 12615680; in_idx = 12; gain_idx = 11; break;
        case 5: K = 512; Nd = 1024; Ns = 1024; off = 12877824; in_idx = 17; break;
        case 6: K = 512; Nd = 1024; Ns = 1024; off = 13402112; in_idx = 18; break;
        case 7: K = 1024; Nd = 1024; Ns = 1024; off = 13926400; in_idx = 19; break;
        case 8: K = 1024; Nd = 5632; Ns = 5632; off = 14974976; in_idx = 21; break;
        default: K = 2816; Nd = 1024; Ns = 1024; off = 20742144; in_idx = 22; break;
    }
}
__device__ __forceinline__ int mat_items(int mat) {
    switch (mat) { case 0: case 8: return 2816; case 1: case 9: return 1408; case 2: return 1792; case 3: return 144; case 4: return 128; case 5: case 6: return 256; default: return 512; }
}
constexpr int ITEMS_PER_LAYER = 2816 + 1408 + 1792 + 144 + 128 + 256 + 256 + 512 + 2816 + 1408;

__device__ __forceinline__ void cvt_item(const float* W, int K, int Ns, int src0, const float* gain, float cscale, bf16* WT, int n0, int k0, LAS float* scr, int lane) {
    float v_[32];
#pragma unroll
    for (int i = 0; i < 32; ++i) {
        const int kk = 2 * i + (lane >> 5);
        v_[i] = 0.f;
        if (src0 >= 0) v_[i] = W[(size_t)(k0 + kk) * Ns + src0 + (lane & 31)];
    }
#pragma unroll
    for (int i = 0; i < 32; ++i) {
        const int kk = 2 * i + (lane >> 5);
        float v = v_[i] * cscale;
        if (gain) v *= gain[k0 + kk];
        scr[kk * 33 + (lane & 31)] = v;
    }
    asm volatile("s_waitcnt lgkmcnt(0)" ::: "memory");
    const int c = lane & 7;
#pragma unroll
    for (int j = 0; j < 4; ++j) {
        const int n = (lane >> 3) + 8 * j; const LAS float* s = scr + (8 * c) * 33 + n;
        v4u o; o.x = pk2(s[0 * 33], s[1 * 33]); o.y = pk2(s[2 * 33], s[3 * 33]); o.z = pk2(s[4 * 33], s[5 * 33]); o.w = pk2(s[6 * 33], s[7 * 33]);
        *(v4u*)(WT + (size_t)(n0 + n) * K + k0 + 8 * c) = o;
    }
    asm volatile("s_waitcnt lgkmcnt(0)" ::: "memory");
}

struct Args { const float* in[23]; float* out; unsigned char* ws; int pad[2]; };
__device__ __forceinline__ const float* in_sel(const Args& a, int idx) {
    switch (idx) {
        case 5: return uni(a.in[5]); case 6: return uni(a.in[6]); case 8: return uni(a.in[8]); case 9: return uni(a.in[9]); case 10: return uni(a.in[10]); case 11: return uni(a.in[11]); case 12: return uni(a.in[12]);
        case 17: return uni(a.in[17]); case 18: return uni(a.in[18]); case 19: return uni(a.in[19]); case 21: return uni(a.in[21]); default: return uni(a.in[22]);
    }
}
__device__ __forceinline__ void p0_prologue(Frame& F, const Args& A, unsigned char* ws) {
    LAS float* scr = (LAS float*)(F.lds + F.wave * 16384);
    const int gw = F.vcu * NWAVES + F.wave, NGW = F.G * NWAVES;
    bf16* WT = (bf16*)(ws + WS_WT);
    for (int it = gw; it < DEPTH * ITEMS_PER_LAYER; it += NGW) {
        const int l = it / ITEMS_PER_LAYER; int r = it % ITEMS_PER_LAYER; int mat = 0;
        for (;;) { const int n = mat_items(mat); if (r < n) break; r -= n; ++mat; }
        int K, Nd, Ns, in_idx, gain_idx; size_t off; mat_info(mat, K, Nd, Ns, off, in_idx, gain_idx);
        const int nblk = Nd / 32, kb = r / nblk, nb = r % nblk, n0 = nb * 32, k0 = kb * 64;
        int src0 = n0; float cscale = 1.0f;
        if (mat == 0 || mat == 8) { const int pn = n0 >> 8, rr = n0 & 255, bj = rr >> 7, cc = rr & 127; src0 = bj * FF + 128 * pn + cc; cscale = bj == 0 ? 1.4426950408889634f : 0.6931471805599453f; }
        else if (mat == 2) { src0 = (n0 < 2048) ? 1440 + n0 : (n0 < 2816) ? 672 + (n0 - 2048) : (n0 < 3488) ? (n0 - 2816) : -1; if (n0 < 2048) cscale = 1.4426950408889634f; }
        const float* W = in_sel(A, in_idx) + (size_t)l * K * Ns;
        const float* gain = gain_idx >= 0 ? in_sel(A, gain_idx) + (size_t)l * K : nullptr;
        cvt_item(W, K, Ns, src0, gain, cscale, WT + (size_t)l * LW + off, n0, k0, scr, F.lane);
    }
    {
        f32x2* CS = (f32x2*)(ws + WS_CS);
        for (int idx = (F.vcu * NTHR + F.tid); idx < 2048 * 16; idx += F.G * NTHR) {
            const int pos = idx >> 4, i = idx & 15;
            const float inv = exp2f(-(float)i * (13.287712379549449f / 16.0f));
            const float ang = (float)pos * inv;
            const double rev = (double)ang * 0.15915494309189535;
            const float fr = (float)(rev - __builtin_rint(rev));
            CS[idx] = (f32x2){__builtin_amdgcn_cosf(fr), __builtin_amdgcn_sinf(fr)};
        }
    }
    __syncthreads();
    {
        LAS float* cs = (LAS float*)F.lds;
        const float* c = uni(A.in[1]);
        float* mod = (float*)(ws + WS_MOD);
        for (int it = F.vcu; it < DEPTH * (NMODC / 64); it += F.G) {
            for (int idx = F.tid; idx < 32 * 1024; idx += NTHR) { const int k = idx >> 5, b = idx & 31; const float v = c[b * 1024 + k]; cs[idx] = v / (1.0f + __expf(-v)); }
            __syncthreads();
            const int l = it / (NMODC / 64), jb = it % (NMODC / 64), col = jb * 64 + F.lane;
            const float* w = uni(A.in[2]) + (size_t)l * 1024 * NMODC + col;
            float acc[32];
#pragma unroll
            for (int b = 0; b < 32; ++b) acc[b] = 0.f;
            const int kbeg = F.wave * 128;
#pragma unroll 4
            for (int k = kbeg; k < kbeg + 128; ++k) {
                const float wv = w[(size_t)k * NMODC];
                const LAS f32x4* cr = (const LAS f32x4*)(cs + k * 32);
#pragma unroll
                for (int b4 = 0; b4 < 8; ++b4) { const f32x4 cv = cr[b4]; acc[4 * b4] += cv[0] * wv; acc[4 * b4 + 1] += cv[1] * wv; acc[4 * b4 + 2] += cv[2] * wv; acc[4 * b4 + 3] += cv[3] * wv; }
            }
            __syncthreads();
            LAS float* red = (LAS float*)F.lds;
#pragma unroll
            for (int b = 0; b < 32; ++b) red[(F.wave * 32 + b) * 64 + F.lane] = acc[b];
            __syncthreads();
#pragma unroll
            for (int q = 0; q < 4; ++q) {
                const int idx = F.tid + NTHR * q, b = idx >> 6, cc = idx & 63;
                float sum = uni(A.in[3])[(size_t)l * NMODC + jb * 64 + cc];
#pragma unroll
                for (int wv = 0; wv < 8; ++wv) sum += red[(wv * 32 + b) * 64 + cc];
                mod[((size_t)l * 32 + b) * NMODC + jb * 64 + cc] = sum;
            }
            __syncthreads();
        }
    }
}

template <int CTRL> __device__ __forceinline__ float dppf(float v) { return __builtin_bit_cast(float, __builtin_amdgcn_update_dpp(0, __builtin_bit_cast(int, v), CTRL, 0xF, 0xF, true)); }
__device__ __forceinline__ float row8_sum(float v) { v += dppf<0xB1>(v); v += dppf<0x4E>(v); v += dppf<0x141>(v); return v; }
__device__ __forceinline__ float row16_sum(float v) { v = row8_sum(v); v += dppf<0x140>(v); return v; }
__device__ __forceinline__ f32x4 ld4bf(const bf16* p) { const v2u w = *(const GASP v2u*)p; return (f32x4){__uint_as_float(w.x << 16), __uint_as_float(w.x & 0xffff0000u), __uint_as_float(w.y << 16), __uint_as_float(w.y & 0xffff0000u)}; }
__device__ __forceinline__ f32x4 up4(v2u w) { return (f32x4){__uint_as_float(w.x << 16), __uint_as_float(w.x & 0xffff0000u), __uint_as_float(w.y << 16), __uint_as_float(w.y & 0xffff0000u)}; }
__device__ __forceinline__ v2u pk4(f32x4 v) { v2u w; w.x = pk2(v[0], v[1]); w.y = pk2(v[2], v[3]); return w; }
__device__ __forceinline__ float dot4(f32x4 x) { return (x[0] * x[0] + x[1] * x[1]) + (x[2] * x[2] + x[3] * x[3]); }
__device__ __forceinline__ f32x4 rope4(f32x4 y, f32x4 cA, f32x4 cB, bool hi) {
    f32x4 p; p[0] = __shfl_xor(y[0], 4); p[1] = __shfl_xor(y[1], 4); p[2] = __shfl_xor(y[2], 4); p[3] = __shfl_xor(y[3], 4);
    if (!hi) p = -p;
    return (f32x4){y[0] * cA[0] + p[0] * cA[1], y[1] * cA[2] + p[1] * cA[3], y[2] * cB[0] + p[2] * cB[1], y[3] * cB[2] + p[3] * cB[3]};
}

__device__ __forceinline__ void norm_phase(Frame& F, const void* h, int h_bf, const float* gain, const float* sh, const float* sc, bf16* U) {
    const int lw = F.xr * NWAVES + F.wave, NLW = F.nx * NWAVES;
    for (int lb = lw; lb < 256; lb += NLW) {
        const int blk = 256 * F.xid + lb;
        const int m0 = blk * 32, b = m0 >> 11;
        f32x4 A[4], B[4];
#pragma unroll
        for (int j = 0; j < 4; ++j) {
            const int col = 256 * j + 4 * F.lane;
            A[j] = *(const GASP f32x4*)(gain + col) * (*(const GASP f32x4*)(sc + (size_t)b * NMODC + col) + 1.0f);
            B[j] = *(const GASP f32x4*)(sh + (size_t)b * NMODC + col);
        }
#pragma unroll 4
        for (int r = 0; r < 32; ++r) {
            const int m = m0 + r;
            f32x4 v[4]; float s = 0.f;
            if (h_bf) {
                const bf16* xr = (const bf16*)h + (size_t)m * DM + 4 * F.lane;
#pragma unroll
                for (int j = 0; j < 4; ++j) { v[j] = ld4bf(xr + 256 * j); s += dot4(v[j]); }
            } else {
                const f32x4* xr = (const f32x4*)((const float*)h + (size_t)m * DM) + F.lane;
#pragma unroll
                for (int j = 0; j < 4; ++j) { v[j] = *(const GASP f32x4*)(xr + 64 * j); s += dot4(v[j]); }
            }
            s = row16_sum(s); s += __shfl_xor(s, 16); s += __shfl_xor(s, 32);
            const float rstd = rsqrtf(s * (1.f / DM) + EPS);
            v2u* o8 = (v2u*)(U + (size_t)m * DM) + F.lane;
#pragma unroll
            for (int j = 0; j < 4; ++j) *(GASP v2u*)(o8 + 64 * j) = pk4(v[j] * rstd * A[j] + B[j]);
        }
    }
}

__device__ __forceinline__ void pp1_phase(Frame& F, unsigned char* ws, const bf16* ZG, const bf16* ZM, const float* gqn, const float* gkn) {
    float* RSQ = (float*)(ws + WS_RSQ); float* RSKV = (float*)(ws + WS_RSKV);
    bf16* QG = (bf16*)(ws + WS_QG); bf16* KG = (bf16*)(ws + WS_KG); bf16* VTG = (bf16*)(ws + WS_VTG);
    const float* CS = (const float*)(ws + WS_CS);
    const int lane = F.lane, a = lane & 15;
    const f32x4 gq4 = *(const GASP f32x4*)(gqn + 4 * a), gk4 = *(const GASP f32x4*)(gkn + 4 * a);
    const bool hi = (a & 4) != 0;
    LAS bf16* stage = (LAS bf16*)F.lds;
    for (int lc = F.xr; lc < 64; lc += F.nx) {
        const int ch = 64 * F.xid + lc;
        const int lr0 = ch * 64, bl = lr0 >> 11, s0 = lr0 & 2047;
#pragma unroll 1
        for (int i0 = 0; i0 < 8; i0 += 4) {
            v2u zq0[4], zq1[4], zkv[4], rw[4][3]; f32x4 cAa[4], cBa[4];
#pragma unroll
            for (int u = 0; u < 4; ++u) {
                const int tk = F.wave * 8 + i0 + u, lr = lr0 + tk, s = s0 + tk;
                const bf16* zg = ZG + (size_t)lr * 768; const bf16* zm = ZM + (size_t)lr * 768;
                zq0[u] = *(const GASP v2u*)(zm + 4 * lane); zq1[u] = (v2u){0u, 0u}; if (lane < 32) zq1[u] = *(const GASP v2u*)(zm + 256 + 4 * lane);
                zkv[u] = *(const GASP v2u*)(zm + 384 + 4 * lane);
                const int pos = (a < 8) ? (s >> 6) : (s & 63);
                cAa[u] = *(const GASP f32x4*)(CS + (pos * 16 + 4 * (a & 3)) * 2); cBa[u] = *(const GASP f32x4*)(CS + (pos * 16 + 4 * (a & 3)) * 2 + 4);
#pragma unroll
                for (int j = 0; j < 3; ++j) rw[u][j] = *(const GASP v2u*)(zg + 256 * j + 4 * lane);
            }
            asm volatile("" ::: "memory");
#pragma unroll
            for (int u = 0; u < 4; ++u) {
                const int tk = F.wave * 8 + i0 + u, lr = lr0 + tk;
                float ss = wave_sum(dot4(up4(zq0[u])) + dot4(up4(zq1[u]))); if (lane == 0) RSQ[lr] = rsqrtf(ss * (1.f / 384.f) + EPS);
                ss = wave_sum(dot4(up4(zkv[u]))); if (lane == 0) RSKV[lr] = rsqrtf(ss * (1.f / 256.f) + EPS);
#pragma unroll
                for (int j = 0; j < 3; ++j) {
                    const v2u raw = rw[u][j];
                    const f32x4 x = up4(raw);
                    const float q = row16_sum(dot4(x));
                    const float r = rsqrtf(q * (1.f / 64.f) + EPS);
                    const f32x4 o = rope4(x * r * (j < 2 ? gq4 : gk4), cAa[u], cBa[u], hi);
                    if (j < 2) *(GASP v2u*)(QG + (size_t)lr * 512 + 256 * j + 4 * lane) = pk4(o * QS_G);
                    else if (lane < 32) *(GASP v2u*)(KG + (size_t)lr * 128 + 4 * lane) = pk4(o);
                    else *(LAS v2u*)(stage + tk * 132 + 4 * (lane - 32)) = raw;
                }
            }
            asm volatile("" ::: "memory");
        }
        __syncthreads();
#pragma unroll
        for (int jj = 0; jj < 2; ++jj) {
            const int it = F.tid + 512 * jj, hd = it >> 3, cc = it & 7;
            unsigned e[8];
#pragma unroll
            for (int j = 0; j < 8; ++j) e[j] = stage[(8 * cc + j) * 132 + hd];
            v4u o; o.x = e[0] | (e[1] << 16); o.y = e[2] | (e[3] << 16); o.z = e[4] | (e[5] << 16); o.w = e[6] | (e[7] << 16);
            *(GASP v4u*)(VTG + ((size_t)(bl * 128 + hd)) * 2048 + s0 + 8 * cc) = o;
        }
        __syncthreads();
    }
}

__device__ __forceinline__ void pp2_phase(Frame& F, unsigned char* ws, const bf16* QRAW, const bf16* KVRAW, const bf16* ZM, const float* gqn, const float* gkn) {
    bf16* QM = (bf16*)(ws + WS_QM); bf16* KM = (bf16*)(ws + WS_KM); bf16* VTM = (bf16*)(ws + WS_VTM);
    const float* CS = (const float*)(ws + WS_CS);
    const int lane = F.lane, a = lane & 15, hh = lane >> 4, a8 = lane & 7, h8 = lane >> 3;
    const f32x4 g0q = *(const GASP f32x4*)(gqn + 4 * a), g1q = *(const GASP f32x4*)(gqn + 64 + 4 * a8), g0k = *(const GASP f32x4*)(gkn + 4 * a), g1k = *(const GASP f32x4*)(gkn + 64 + 4 * a8);
    const bool hi = (a8 & 4) != 0;
    LAS bf16* stage = (LAS bf16*)F.lds;
    for (int lc = F.xr; lc < 64; lc += F.nx) {
        const int ch = 64 * F.xid + lc;
        const int lr0 = ch * 64, bl = lr0 >> 11, s0 = lr0 & 2047;
#pragma unroll 1
        for (int i0 = 0; i0 < 8; i0 += 4) {
            v2u xrw[4], xnw[4][2], krw[4], knw[4][2], vw[4][2]; f32x4 cAa[4], cBa[4];
#pragma unroll
            for (int u = 0; u < 4; ++u) {
                const int tk = F.wave * 8 + i0 + u, lr = lr0 + tk, s = s0 + tk;
                const bf16* qr = QRAW + (size_t)lr * 768; const bf16* kvr = KVRAW + (size_t)lr * 1024; const bf16* zm = ZM + (size_t)lr * 768;
                cAa[u] = *(const GASP f32x4*)(CS + (s * 16 + 4 * (a8 & 3)) * 2); cBa[u] = *(const GASP f32x4*)(CS + (s * 16 + 4 * (a8 & 3)) * 2 + 4);
                xrw[u] = *(const GASP v2u*)(qr + 96 * h8 + 64 + 4 * a8);
                krw[u] = *(const GASP v2u*)(zm + 640 + 4 * a8);
#pragma unroll
                for (int p = 0; p < 2; ++p) {
                    xnw[u][p] = *(const GASP v2u*)(qr + 96 * (4 * p + hh) + 4 * a);
                    knw[u][p] = *(const GASP v2u*)(kvr + 128 * (4 * p + hh) + 4 * a);
                    vw[u][p] = *(const GASP v2u*)(kvr + 128 * (4 * p + hh) + 64 + 4 * a);
                }
            }
            asm volatile("" ::: "memory");
#pragma unroll
            for (int u = 0; u < 4; ++u) {
                const int tk = F.wave * 8 + i0 + u, lr = lr0 + tk;
                const f32x4 cA = cAa[u], cB = cBa[u];
                {
                    const f32x4 xr = up4(xrw[u]);
                    const float ssr = row8_sum(dot4(xr));
                    float rp[2];
#pragma unroll
                    for (int p = 0; p < 2; ++p) {
                        const f32x4 xn = up4(xnw[u][p]);
                        const float ssn = row16_sum(dot4(xn));
                        const float ssrh = __shfl(ssr, 32 * p + 8 * hh);
                        const float r = rsqrtf((ssn + ssrh) * (1.f / 96.f) + EPS); rp[p] = r;
                        *(GASP v2u*)(QM + (size_t)lr * 768 + 96 * (4 * p + hh) + 4 * a) = pk4(xn * g0q * (r * QS_M));
                    }
                    const float r0 = __shfl(rp[0], 16 * (h8 & 3)), r1 = __shfl(rp[1], 16 * (h8 & 3));
                    const float rr = (h8 < 4) ? r0 : r1;
                    const f32x4 o = rope4(xr * g1q * rr, cA, cB, hi);
                    *(GASP v2u*)(QM + (size_t)lr * 768 + 96 * h8 + 64 + 4 * a8) = pk4(o * QS_M);
                }
                {
                    const f32x4 kr = up4(krw[u]);
                    const float sspe = row8_sum(dot4(kr));
                    float rp[2];
#pragma unroll
                    for (int p = 0; p < 2; ++p) {
                        const f32x4 xn = up4(knw[u][p]);
                        const float ssn = row16_sum(dot4(xn));
                        const float r = rsqrtf((ssn + sspe) * (1.f / 96.f) + EPS); rp[p] = r;
                        *(GASP v2u*)(KM + (size_t)lr * 768 + 96 * (4 * p + hh) + 4 * a) = pk4(xn * g0k * r);
                        *(LAS v2u*)(stage + tk * 516 + 64 * (4 * p + hh) + 4 * a) = vw[u][p];
                    }
                    const float r0 = __shfl(rp[0], 16 * (h8 & 3)), r1 = __shfl(rp[1], 16 * (h8 & 3));
                    const float rr = (h8 < 4) ? r0 : r1;
                    const f32x4 o = rope4(kr * g1k * rr, cA, cB, hi);
                    *(GASP v2u*)(KM + (size_t)lr * 768 + 96 * h8 + 64 + 4 * a8) = pk4(o);
                }
            }
            asm volatile("" ::: "memory");
        }
        __syncthreads();
#pragma unroll 2
        for (int jj = 0; jj < 8; ++jj) {
            const int it = F.tid + 512 * jj, hd = it >> 3, cc = it & 7;
            unsigned e[8];
#pragma unroll
            for (int j = 0; j < 8; ++j) e[j] = stage[(8 * cc + j) * 516 + hd];
            v4u o; o.x = e[0] | (e[1] << 16); o.y = e[2] | (e[3] << 16); o.z = e[4] | (e[5] << 16); o.w = e[6] | (e[7] << 16);
            *(GASP v4u*)(VTM + ((size_t)(bl * 512 + hd)) * 2048 + s0 + 8 * cc) = o;
        }
        __syncthreads();
    }
}

typedef __bf16 bf16x2_t __attribute__((ext_vector_type(2)));
__device__ __forceinline__ unsigned cvtpk(float lo, float hi) { const f32x2 v = {lo, hi}; const bf16x2_t b = __builtin_convertvector(v, bf16x2_t); return __builtin_bit_cast(unsigned, b); }
#define ATT_BAR() asm volatile("s_waitcnt lgkmcnt(0)\n\ts_barrier" ::: "memory")
template <int DQ>
__device__ __forceinline__ void attn_branch(Frame& F, const bf16* Qb, int ldq, int qhs, const bf16* Kb, int ldk, int khs, int kvshift, const bf16* Vtb, int nkv, bf16* Ob) {
    LAS unsigned char* lds = F.lds;
    int tid = F.tid; asm volatile("" : "+v"(tid));
    const int lane = tid & 63, wave = __builtin_amdgcn_readfirstlane(tid >> 6);
    constexpr int KP = DQ * 2 + 16, VP = 144, KBUF = 64 * KP, VBUF = 64 * VP, ND = DQ / 16, KCH = DQ / 8, NKC = 64 * KCH, NT = SEQ / 64;
    constexpr bool K2 = NKC > 512;
    constexpr float THR = 8.0f;
    const int q = lane & 31, hi = lane >> 5;
    bf16x8 qf[ND];
    v4u a_k0, a_k1 = (v4u){0u, 0u, 0u, 0u}, a_v, b_k0, b_k1 = (v4u){0u, 0u, 0u, 0u}, b_v;
    bool first = true;
    for (int lu = F.xr; lu < 128; lu += F.nx) {
    const int ln_ = (lu + F.nx < 128) ? lu + F.nx : lu;
    const int bl_ = 2 * F.xid + (lu >> 6), h_ = (lu >> 3) & 7, qb_ = lu & 7, bln_ = 2 * F.xid + (ln_ >> 6), hn_ = (ln_ >> 3) & 7, qbn_ = ln_ & 7;
    const bf16* Qp = Qb + ((size_t)bl_ * 2048 + qb_ * 256) * ldq + h_ * qhs; const bf16* Kp = Kb + (size_t)bl_ * 2048 * ldk + (h_ >> kvshift) * khs;
    const bf16* Vtp = Vtb + (size_t)((bl_ * nkv + (h_ >> kvshift)) * 64) * 2048; bf16* Op = Ob + ((size_t)bl_ * 2048 + qb_ * 256) * 512 + h_ * 64;
    const bf16* Qp_n = Qb + ((size_t)bln_ * 2048 + qbn_ * 256) * ldq + hn_ * qhs; const bf16* Kp_n = Kb + (size_t)bln_ * 2048 * ldk + (hn_ >> kvshift) * khs;
    const bf16* Vtp_n = Vtb + (size_t)((bln_ * nkv + (hn_ >> kvshift)) * 64) * 2048;
    if (first) {
#pragma unroll
        for (int d0 = 0; d0 < ND; ++d0) qf[d0] = *(const GASP bf16x8*)(Qp + (size_t)(wave * 32 + q) * ldq + d0 * 16 + hi * 8);
    }
    const int kr0 = tid / KCH, kc0 = tid % KCH, kr1 = (tid + 512) / KCH, kc1 = (tid + 512) % KCH;
    const bool k1v = K2 && (tid + 512 < NKC);
    const unsigned kg0 = (unsigned)(kr0 * ldk + kc0 * 8) * 2u;
    const unsigned kg1 = (unsigned)((k1v ? kr1 : 0) * ldk + (k1v ? kc1 : 0) * 8) * 2u;
    const int vd = tid >> 3, vc = tid & 7;
    const unsigned vg = (unsigned)(vd * 2048 + vc * 8) * 2u;
    const int ks0 = kr0 * KP + kc0 * 16, ks1 = kr1 * KP + kc1 * 16, vs = 2 * KBUF + vd * VP + vc * 16;
    const int pq = (q & 0x13) | ((q & 4) << 1) | ((q & 8) >> 1);
    const int ka = pq * KP + hi * 16, va = 2 * KBUF + q * VP + hi * 16;
#define LOADK(R, tile) do { const char* kt_ = (const char*)(Kp + (size_t)(tile) * 64 * ldk); R##_k0 = *(const GASP v4u*)(kt_ + kg0); if (K2) { if (k1v) R##_k1 = *(const GASP v4u*)(kt_ + kg1); } } while (0)
#define LOADV(R, tile) do { R##_v = *(const GASP v4u*)((const char*)(Vtp + (tile) * 64) + vg); } while (0)
#define STOREK(R, buf) do { *(LAS v4u*)(lds + (buf) * KBUF + ks0) = R##_k0; if (K2) { if (k1v) *(LAS v4u*)(lds + (buf) * KBUF + ks1) = R##_k1; } } while (0)
#define STOREV(R, buf) do { *(LAS v4u*)(lds + (buf) * VBUF + vs) = R##_v; } while (0)
#define QKT(S0, S1, buf, C0, C1) do { const LAS unsigned char* Kb_ = lds + (buf) * KBUF + ka; \
        _Pragma("unroll") for (int d0 = 0; d0 < ND; ++d0) { \
            const bf16x8 a0_ = *(const LAS bf16x8*)(Kb_ + d0 * 32), a1_ = *(const LAS bf16x8*)(Kb_ + 32 * KP + d0 * 32); \
            S0 = __builtin_amdgcn_mfma_f32_32x32x16_bf16(a0_, qf[d0], d0 == 0 ? C0 : S0, 0, 0, 0); \
            S1 = __builtin_amdgcn_mfma_f32_32x32x16_bf16(a1_, qf[d0], d0 == 0 ? C1 : S1, 0, 0, 0); } } while (0)
#define PVT(buf) do { const LAS unsigned char* Vb_ = lds + (buf) * VBUF + va; \
        _Pragma("unroll") for (int jj = 0; jj < 4; ++jj) { \
            const bf16x8 v0_ = *(const LAS bf16x8*)(Vb_ + jj * 32), v1_ = *(const LAS bf16x8*)(Vb_ + 32 * VP + jj * 32); \
            const bf16x8 pf_ = __builtin_bit_cast(bf16x8, pw[jj]); \
            o0 = __builtin_amdgcn_mfma_f32_32x32x16_bf16(v0_, pf_, o0, 0, 0, 0); \
            o1 = __builtin_amdgcn_mfma_f32_32x32x16_bf16(v1_, pf_, o1, 0, 0, 0); } } while (0)
    if (first) { LOADK(a, 0); LOADK(b, 1); LOADV(a, 0); }
    STOREK(a, 0); STOREK(b, 1); STOREV(a, 1);
    LOADK(a, 2); LOADK(b, 3); LOADV(b, 1);
    ATT_BAR();
    f32x16 zero16, sc0, sc1, sn0, sn1, o0, o1, negm;
#pragma unroll
    for (int r = 0; r < 16; ++r) { zero16[r] = 0.f; o0[r] = 0.f; o1[r] = 0.f; }
    QKT(sc0, sc1, 0, zero16, zero16);
    float l_run = 0.f;
    {
        float mx = fmaxf(sc0[0], sc1[0]);
#pragma unroll
        for (int r = 1; r < 16; ++r) mx = fmaxf(mx, fmaxf(sc0[r], sc1[r]));
        mx = fmaxf(mx, __shfl_xor(mx, 32));
#pragma unroll
        for (int r = 0; r < 16; ++r) { sc0[r] -= mx; sc1[r] -= mx; negm[r] = -mx; }
    }
    v4u pw[4];
#pragma unroll
    for (int jj = 0; jj < 4; ++jj) pw[jj] = (v4u){0u, 0u, 0u, 0u};
#define FRAG_ADDR(i, BQ, BP) (((i) < 2 * ND) ? (lds + (BQ) * KBUF + ka + ((i) & 1) * 32 * KP + ((i) >> 1) * 32) \
                                             : (lds + (BP) * VBUF + va + (((i) - 2 * ND) & 1) * 32 * VP + (((i) - 2 * ND) >> 1) * 32))
#define SLICE(k, SC0, SC1, PW) do { \
        float e0_, e1_; \
        if ((k) < 8) { e0_ = __builtin_amdgcn_exp2f(SC0[2 * (k)]); e1_ = __builtin_amdgcn_exp2f(SC0[2 * (k) + 1]); } \
        else { e0_ = __builtin_amdgcn_exp2f(SC1[2 * (k) - 16]); e1_ = __builtin_amdgcn_exp2f(SC1[2 * (k) - 15]); } \
        lsA_ += e0_; lsB_ += e1_; \
        unsigned w_ = cvtpk(e0_, e1_); asm volatile("" : "+v"(w_), "+v"(lsA_), "+v"(lsB_)); PW[(k) >> 2][(k) & 3] = w_; \
    } while (0)
#define STAGE(t, R, BQ, BP, BS, PR, PW, SC0, SC1, SN0, SN1) do { \
        constexpr int NQ_ = 2 * ND, NM_ = NQ_ + 8; \
        constexpr int FD_ = 3, FR_ = FD_ + 1, SL0_ = 3;     \
        bf16x8 fr_[FR_]; \
        _Pragma("unroll") for (int i = 0; i < FD_; ++i) fr_[i] = *(const LAS bf16x8*)FRAG_ADDR(i, BQ, BP); \
        float lsA_ = 0.f, lsB_ = 0.f, mx_ = -INFINITY; \
        _Pragma("unroll") for (int k = 0; k < SL0_; ++k) { SLICE(k, SC0, SC1, PW); } \
        __builtin_amdgcn_sched_barrier(0); \
        _Pragma("unroll") for (int i = 0; i < NM_; ++i) { \
            if (i + FD_ < NM_) fr_[(i + FD_) % FR_] = *(const LAS bf16x8*)FRAG_ADDR(i + FD_, BQ, BP); \
            if (i < NQ_) { \
                const int d0_ = i >> 1; \
                if ((i & 1) == 0) SN0 = __builtin_amdgcn_mfma_f32_32x32x16_bf16(fr_[i % FR_], qf[d0_], d0_ == 0 ? negm : SN0, 0, 0, 0); \
                else              SN1 = __builtin_amdgcn_mfma_f32_32x32x16_bf16(fr_[i % FR_], qf[d0_], d0_ == 0 ? negm : SN1, 0, 0, 0); \
            } else { \
                const int j_ = i - NQ_; const bf16x8 pf_ = __builtin_bit_cast(bf16x8, PR[j_ >> 1]); \
                if ((j_ & 1) == 0) o0 = __builtin_amdgcn_mfma_f32_32x32x16_bf16(fr_[i % FR_], pf_, o0, 0, 0, 0); \
                else               o1 = __builtin_amdgcn_mfma_f32_32x32x16_bf16(fr_[i % FR_], pf_, o1, 0, 0, 0); \
            } \
            if (i + SL0_ < 16) { SLICE(i + SL0_, SC0, SC1, PW); }                  \
            if (i >= NM_ - 6) { \
                _Pragma("unroll") for (int r = 3 * (i - (NM_ - 6)); r < 3 * (i - (NM_ - 6)) + 3; ++r) if (r < 16) mx_ = fmaxf(fmaxf(mx_, SN0[r]), SN1[r]); \
                asm volatile("" : "+v"(mx_)); \
            } \
            if (i == 13) { STOREK(R, BS); }                    \
            if (i == 14) { STOREV(R, BS); } \
            if (i == 15) { const int tk_ = ((t) + 4 < NT) ? (t) + 4 : NT - 1, tv_ = ((t) + 2 < NT) ? (t) + 2 : NT - 1; LOADK(R, tk_); LOADV(R, tv_); } \
            __builtin_amdgcn_sched_barrier(0); \
        } \
        l_run = l_run * al_pend + (lsA_ + lsB_); \
        ATT_BAR(); \
        if (pend) { _Pragma("unroll") for (int r = 0; r < 16; ++r) { o0[r] *= al_pend; o1[r] *= al_pend; } } \
        pend = false; al_pend = 1.0f; \
        if (__any(mx_ > THR)) { \
            const float rm_ = fmaxf(mx_, __shfl_xor(mx_, 32)); \
            const float dl_ = fmaxf(rm_, 0.f); \
            al_pend = __builtin_amdgcn_exp2f(-dl_); pend = true; \
            _Pragma("unroll") for (int r = 0; r < 16; ++r) { SN0[r] -= dl_; SN1[r] -= dl_; negm[r] -= dl_; } \
        } \
    } while (0)
    float al_pend = 1.0f; bool pend = false;
    v4u pw2[4];
    for (int t = 0; t < NT; t += 2) {
        STAGE(t, a, 1, 1, 0, pw, pw2, sc0, sc1, sn0, sn1);
        STAGE(t + 1, b, 0, 0, 1, pw2, pw, sn0, sn1, sc0, sc1);
    }
#undef FRAG_ADDR
#undef SLICE
    {
        const char* kn_ = (const char*)Kp_n;
        a_k0 = *(const GASP v4u*)(kn_ + kg0); b_k0 = *(const GASP v4u*)(kn_ + (size_t)64 * ldk * 2 + kg0);
        if (K2) { if (k1v) { a_k1 = *(const GASP v4u*)(kn_ + kg1); b_k1 = *(const GASP v4u*)(kn_ + (size_t)64 * ldk * 2 + kg1); } }
        a_v = *(const GASP v4u*)((const char*)Vtp_n + vg);
#pragma unroll
        for (int d0 = 0; d0 < ND; ++d0) qf[d0] = *(const GASP bf16x8*)(Qp_n + (size_t)(wave * 32 + q) * ldq + d0 * 16 + hi * 8);
    }
    PVT(1);
    l_run += __shfl_xor(l_run, 32);
    const float inv = __builtin_amdgcn_rcpf(l_run);
    bf16* orow = Op + (size_t)(wave * 32 + q) * 512 + 4 * hi;
#pragma unroll
    for (int a = 0; a < 4; ++a) {
        v2u w0, w1;
        w0.x = cvtpk(o0[4 * a] * inv, o0[4 * a + 1] * inv); w0.y = cvtpk(o0[4 * a + 2] * inv, o0[4 * a + 3] * inv);
        w1.x = cvtpk(o1[4 * a] * inv, o1[4 * a + 1] * inv); w1.y = cvtpk(o1[4 * a + 2] * inv, o1[4 * a + 3] * inv);
        *(GASP v2u*)(orow + 8 * a) = w0; *(GASP v2u*)(orow + 32 + 8 * a) = w1;
    }
    ATT_BAR();
    first = false;
    }
#undef LOADK
#undef LOADV
#undef STOREK
#undef STOREV
#undef QKT
#undef PVT
#undef STAGE
}

__device__ __forceinline__ void attn_phase(Frame& F, unsigned char* ws) {
    attn_branch<96>(F, (const bf16*)(ws + WS_QM), 768, 96, (const bf16*)(ws + WS_KM), 768, 96, 0, (const bf16*)(ws + WS_VTM), 8, (bf16*)(ws + WS_OM));
    attn_branch<64>(F, (const bf16*)(ws + WS_QG), 512, 64, (const bf16*)(ws + WS_KG), 128, 64, 2, (const bf16*)(ws + WS_VTG), 2, (bf16*)(ws + WS_OG));
}

typedef __attribute__((address_space(1))) unsigned gu32;
#define XB_TMO      128
#define XB_XCNT(j)  (256  + 64 * (j))
#define XB_XSUB(j)  (1280 + 64 * (j))
#define XB_XGEN(j)  (2304 + 64 * (j))
#define XB_TOP      3328
#define XB_TOPGEN   3392
#define XCD_BAR_WORDS 3456
#define XB_SPIN_CAP (1u << 18)

__device__ __forceinline__ unsigned xb_ld(unsigned* p)              { return __hip_atomic_load(p, __ATOMIC_RELAXED, __HIP_MEMORY_SCOPE_AGENT); }
__device__ __forceinline__ unsigned xb_add(unsigned* p, unsigned v) { return __hip_atomic_fetch_add(p, v, __ATOMIC_RELAXED, __HIP_MEMORY_SCOPE_AGENT); }
__device__ __forceinline__ unsigned xb_xcc_id() { return (unsigned)__builtin_amdgcn_s_getreg((3 << 11) | 20) & 0xFu; }
#define XB_SPIN(cond, bar) do { unsigned _sp = 0; while (cond) { __builtin_amdgcn_s_sleep(1); \
    if ((++_sp & 255u) == 0u) { if (xb_ld(&(bar)[XB_TMO])) break; if (_sp > XB_SPIN_CAP) { atomicAdd(&(bar)[XB_TMO], 1u); break; } } } } while (0)

struct XcdBarrier {
    unsigned* bar; unsigned x;
    volatile LAS unsigned* st;
};

__device__ __forceinline__ XcdBarrier xcd_barrier_post(unsigned* bar, volatile LAS unsigned* st) {
    XcdBarrier b; b.bar = bar; b.x = xb_xcc_id(); b.st = st;
    if (threadIdx.x == 0) (void)xb_add(&bar[XB_XCNT(b.x)], 1u);
    return b;
}
__device__ __forceinline__ void xcd_barrier_complete(unsigned* bar, unsigned x, unsigned& nloc, unsigned& nx) {
    const unsigned G = gridDim.x * gridDim.y * gridDim.z;
    unsigned sum, cnt, mine, sp = 0u;
    for (;;) {
        sum = 0u; cnt = 0u; mine = 0u;
#pragma unroll
        for (unsigned j = 0; j < 16; ++j) { const unsigned c = xb_ld(&bar[XB_XCNT(j)]); sum += c; cnt += (c > 0u) ? 1u : 0u; mine = (j == x) ? c : mine; }
        if (sum == G) break;
        __builtin_amdgcn_s_sleep(1);
        if ((++sp & 255u) == 0u) { if (xb_ld(&bar[XB_TMO])) break; if (sp > XB_SPIN_CAP) { atomicAdd(&bar[XB_TMO], 1u); break; } }
    }
    nloc = mine > 0u ? mine : 1u; nx = cnt > 0u ? cnt : 1u;
}

__device__ __forceinline__ void xcd_barrier(const XcdBarrier& b) {
    asm volatile("s_waitcnt vmcnt(0)" ::: "memory");
    __syncthreads();
    if (threadIdx.x == 0) {
        unsigned* bar = b.bar;
        __builtin_amdgcn_s_waitcnt(0);
        unsigned nloc = b.st[0], nx = b.st[1];
        if (nloc == 0u) { xcd_barrier_complete(bar, b.x, nloc, nx); b.st[0] = nloc; b.st[1] = nx; }
        const unsigned old = xb_add(&bar[XB_XSUB(b.x)], 1u);
        const unsigned gen = old / nloc;
        if (old + 1u == (gen + 1u) * nloc) {
            __builtin_amdgcn_fence(__ATOMIC_RELEASE, "agent");
            asm volatile("s_waitcnt vmcnt(0)" ::: "memory");
            const unsigned og = xb_add(&bar[XB_TOP], 1u);
            const unsigned tg = og / nx;
            if (og + 1u == (tg + 1u) * nx) xb_add(&bar[XB_TOPGEN], 1u);
            else XB_SPIN(xb_ld(&bar[XB_TOPGEN]) == tg, bar);
            __builtin_amdgcn_fence(__ATOMIC_ACQUIRE, "agent");
            xb_add(&bar[XB_XGEN(b.x)], 1u);
            asm volatile("s_waitcnt vmcnt(0)" ::: "memory");
        } else {
            XB_SPIN(xb_ld(&bar[XB_XGEN(b.x)]) == gen, bar);
            __builtin_amdgcn_fence(__ATOMIC_ACQUIRE, "agent");
            asm volatile("s_waitcnt vmcnt(0)" ::: "memory");
        }
    }
    __syncthreads();
}

#define LB_SUB(j) (XCD_BAR_WORDS + 64 * (j))
#define LB_GEN(j) (XCD_BAR_WORDS + 512 + 64 * (j))
__device__ __forceinline__ void xcd_local_barrier(unsigned* bar, unsigned x, unsigned nx) {
    asm volatile("s_waitcnt vmcnt(0)" ::: "memory");
    __syncthreads();
    if (threadIdx.x == 0) {
        const unsigned old = xb_add(&bar[LB_SUB(x)], 1u);
        const unsigned gen = old / nx;
        if (old + 1u == (gen + 1u) * nx) xb_add(&bar[LB_GEN(x)], 1u);
        else XB_SPIN(xb_ld(&bar[LB_GEN(x)]) == gen, bar);
        __builtin_amdgcn_fence(__ATOMIC_ACQUIRE, "agent");
        asm volatile("s_waitcnt vmcnt(0)" ::: "memory");
    }
    __syncthreads();
}

template <class Epi>
__device__ __forceinline__ void run_gemm(Frame& F, const bf16* A, int lda, const bf16* Bt, int pm0, int LP, int N, int K, const Epi& E, int rev = 0) {
    pg8::Gemm g{A, Bt, TOK, N, K, lda}; pg8::XcdOrder S; S.init(pm0, LP, N, F.xr, F.nx, rev);
    pg8::gemm_phase<Epi, pg8::XcdOrder, true, true>(F.lds, g, S, E, F.tid);
}

constexpr int STEPS_PER_LAYER = 21, NSTEPS = 1 + DEPTH * STEPS_PER_LAYER;

__global__ void __launch_bounds__(NTHR, 2) fwd_megakernel(Args args) {
    extern __shared__ __attribute__((aligned(16))) unsigned char lds_raw[];
    cg::grid_group grid = cg::this_grid();
    const Args* ap = (const Args*)__builtin_amdgcn_kernarg_segment_ptr();
    volatile LAS unsigned* bst = (volatile LAS unsigned*)((LAS unsigned char*)lds_raw + 131072 + 64);
    if (threadIdx.x < 8) bst[threadIdx.x] = 0u;
    __syncthreads();
    for (int step = 0; step < NSTEPS; ++step) {
        asm volatile("" : "+s"(ap));
        const Args& args_ = *ap;
        Frame F;
        F.lds = (LAS unsigned char*)lds_raw;
        { int t_ = threadIdx.x; asm volatile("" : "+v"(t_)); F.tid = t_; }
        F.lane = F.tid & 63; F.wave = __builtin_amdgcn_readfirstlane(F.tid >> 6);
        { int b_ = blockIdx.x, g_ = gridDim.x; asm volatile("" : "+s"(b_), "+s"(g_)); F.bx = b_; F.G = g_; }
        F.vcu = (F.G % 8 == 0) ? (F.bx % 8) * (F.G / 8) + F.bx / 8 : F.bx;
        const bool local_ok = __builtin_amdgcn_readfirstlane(bst[4]) != 0u;
        if (local_ok) { F.xid = __builtin_amdgcn_readfirstlane(bst[2]); F.xr = __builtin_amdgcn_readfirstlane(bst[3]); F.nx = __builtin_amdgcn_readfirstlane(bst[0]); }
        else { F.xid = F.bx % 8; F.xr = F.bx / 8; F.nx = (F.G - F.xid + 7) / 8; }
        unsigned char* ws = uni(args_.ws);
        float* out = uni(args_.out);
        bool chip_wide = false;
        if (step == 0) {
            if (F.bx == 0) for (int i = F.tid; i < XCD_BAR_WORDS + 1024; i += NTHR) ((unsigned*)(ws + WS_BAR))[i] = 0u;
            p0_prologue(F, args_, ws);
        } else {
            const int sidx = step - 1, l = sidx / STEPS_PER_LAYER, ps = sidx % STEPS_PER_LAYER;
            int kind, hf = 0;
            if (ps < 4) kind = ps; else if (ps < 18) { hf = (ps - 4) / 7; kind = 4 + (ps - 4) % 7; } else kind = 11 + (ps - 18);
            chip_wide = false;
            const float* modl = (const float*)(ws + WS_MOD) + (size_t)l * 32 * NMODC;
            const bf16* W = (const bf16*)(ws + WS_WT) + (size_t)l * LW;
#define U_ ((bf16*)(ws + WS_U))
#define HID_ ((bf16*)(ws + WS_HID))
            const size_t hlo = (size_t)4096 * F.xid, fro = hlo + (size_t)4096 * hf;
            unsigned char* arena = ws + WS_X + (size_t)F.xid * ARENA;
            bf16* Gh = (bf16*)(arena + AR_G) - hlo * 2048; bf16* ZGh = (bf16*)(arena + AR_ZG) - hlo * 768; bf16* ZMh = (bf16*)(arena + AR_ZM) - hlo * 768;
            bf16* QRh = (bf16*)(arena + AR_QRAW) - hlo * 768; bf16* KVh = (bf16*)(arena + AR_KVRAW) - hlo * 1024;
            const int pmF = 32 * F.xid, pmH = 32 * F.xid + 16 * hf;
            if (kind == 0 || kind == 3 || kind == 11) {
                const bool fromx = (kind == 0 && l == 0);
                const void* hin = fromx ? (const void*)uni(args_.in[0]) : (const void*)(ws + WS_H);
                const float* gain = (kind == 0 ? uni(args_.in[4]) : kind == 3 ? uni(args_.in[7]) : uni(args_.in[20])) + l * DM;
                const int mi = (kind == 0) ? 0 : (kind == 3) ? 3 : 6;
                norm_phase(F, hin, fromx ? 0 : 1, gain, modl + mi * DM, modl + (mi + 1) * DM, U_);
            } else if (kind == 1 || kind == 12) {
                pg8::EpiB<0> E{HID_, FF, nullptr, nullptr, nullptr, nullptr, 0};
                run_gemm(F, U_, DM, W + (kind == 1 ? (size_t)0 : (size_t)14974976), pmF, 32, 2 * FF, DM, E);
            } else if (kind == 2 || kind == 10 || kind == 13) {
                if (kind == 10) {
                    bf16* hh = (bf16*)(ws + WS_H);
                    pg8::EpiRes E{hh, hh, modl + 5 * DM, 1.0f, 0, 1, 1};
                    run_gemm(F, (const bf16*)(ws + WS_MG) - fro * 1024, 1024, W + 13926400, pmH, 16, DM, DM, E);
                } else {
                    const bool fromx = (kind == 2 && l == 0), last = (kind == 13 && l == DEPTH - 1);
                    const void* hin = fromx ? (const void*)uni(args_.in[0]) : (const void*)(ws + WS_H);
                    void* hout = last ? (void*)out : (void*)(ws + WS_H);
                    pg8::EpiRes E{hin, hout, modl + (kind == 2 ? 2 : 8) * DM, 0.5f, 0, fromx ? 0 : 1, last ? 0 : 1};
                    run_gemm(F, HID_, FF, W + (kind == 2 ? (size_t)5767168 : (size_t)20742144), pmF, 32, DM, FF, E, 1);
                }
            } else if (kind == 4) {
                pg8::EpiB<1> E{Gh - fro * 2048, 2048, ZGh - fro * 768, ZMh - fro * 768, nullptr, nullptr, 0};
                run_gemm(F, U_, DM, W + 8650752, pmH, 16, 3584, DM, E);
            } else if (kind == 5) {
                pp1_phase(F, ws, ZGh, ZMh, uni(args_.in[15]) + l * 64, uni(args_.in[16]) + l * 64);
            } else if (kind == 6) {
                for (int w = 0; w < 2; ++w) {
                    pg8::EpiB<2> E{(w == 0 ? QRh - fro * 768 : KVh - fro * 1024), w == 0 ? 768 : 1024, nullptr, nullptr, nullptr, (const float*)(ws + (w == 0 ? WS_RSQ : WS_RSKV)) - fro, 0};
                    run_gemm(F, ZMh - fro * 768 + (w == 0 ? 0 : 384), 768, W + (w == 0 ? (size_t)12320768 : (size_t)12615680), pmH, 16, w == 0 ? 768 : 1024, w == 0 ? 384 : 256, E);
                }
            } else if (kind == 7) {
                pp2_phase(F, ws, QRh, KVh, ZMh, uni(args_.in[13]) + l * 96, uni(args_.in[14]) + l * 96);
            } else if (kind == 8) {
                attn_phase(F, ws);
            } else if (kind == 9) {
                for (int w = 0; w < 2; ++w) {
                    pg8::EpiB<3> E{(bf16*)(ws + WS_MG) - fro * 1024, 1024, nullptr, nullptr, Gh - fro * 2048, nullptr, w};
                    run_gemm(F, (const bf16*)(ws + (w == 0 ? WS_OM : WS_OG)) - fro * 512, 512, W + (w == 0 ? (size_t)12877824 : (size_t)13402112), pmH, 16, DM, 512, E);
                }
            }
        }
        unsigned* barw = (unsigned*)(ws + WS_BAR);
        if (step == 0) {
            grid.sync();
            if (threadIdx.x == 0) { const unsigned x = xb_xcc_id(); bst[2] = x; bst[3] = xb_add(&barw[XB_XCNT(x)], 1u); }
            __syncthreads();
            XcdBarrier bar; bar.bar = barw; bar.x = xb_xcc_id(); bar.st = bst;
            xcd_barrier(bar);
            if (threadIdx.x == 0) {
                bool ok = true;
                for (unsigned j = 0; j < 16; ++j) { const unsigned c = xb_ld(&barw[XB_XCNT(j)]); ok = ok && ((j < 8) ? (c > 0u) : (c == 0u)); }
                bst[4] = (ok && xb_ld(&barw[XB_TMO]) == 0u) ? 1u : 0u;
            }
            __syncthreads();
        } else if (step + 1 < NSTEPS) {
            if (local_ok && !chip_wide) xcd_local_barrier(barw, (unsigned)F.xid, (unsigned)F.nx);
            else { XcdBarrier bar; bar.bar = barw; bar.x = xb_xcc_id(); bar.st = bst; xcd_barrier(bar); }
        }
    }
}

extern "C" void kernel_launch(void* const* d_in, const int* in_sizes, int n_in, void* d_out, int out_size, void* d_ws, size_t ws_size, hipStream_t stream) {
    static int grid = 0;
    if (grid == 0) {
        if (n_in != 23 || out_size != TOK * DM || ws_size < WS_END) { fprintf(stderr, "kernel_launch: unexpected shapes (n_in %d, out %d, ws %zu < %zu)\n", n_in, out_size, ws_size, (size_t)WS_END); grid = -1; return; }
        int dev = 0, cus = 0, per_cu = 0;
        hipGetDevice(&dev);
        hipDeviceGetAttribute(&cus, hipDeviceAttributeMultiprocessorCount, dev);
        hipFuncSetAttribute((const void*)fwd_megakernel, hipFuncAttributeMaxDynamicSharedMemorySize, LDS_BYTES);
        hipOccupancyMaxActiveBlocksPerMultiprocessor(&per_cu, (const void*)fwd_megakernel, NTHR, LDS_BYTES);
        if (per_cu < 1) per_cu = 1;
        grid = cus * per_cu;
        (void)hipGetLastError();
    }
    if (grid < 0) return;
    Args a{};
    for (int i = 0; i < 23; ++i) a.in[i] = (const float*)d_in[i];
    a.out = (float*)d_out; a.ws = (unsigned char*)d_ws;
    void* kargs[] = {&a};
    hipError_t e = hipLaunchCooperativeKernel((const void*)fwd_megakernel, dim3(grid), dim3(NTHR), kargs, LDS_BYTES, stream);
    if (e != hipSuccess) fprintf(stderr, "cooperative launch failed: %s (grid %d)\n", hipGetErrorString(e), grid);
}
```
